# Optimizing an MI355X kernel written in HIP

```python
import math
import jax, jax.numpy as jnp
from jax import lax
import numpy as np


D_MODEL = 1024
BATCH = 1
SEQ = 16384
DEPTH = 4

HEAD_DIM = 64
RET_HEADS = (3 * D_MODEL // 8) // HEAD_DIM
RET_WIDTH = RET_HEADS * HEAD_DIM
SWA_Q_HEADS = (3 * D_MODEL // 8) // HEAD_DIM
SWA_KV_HEADS = 2
SWA_GROUP = SWA_Q_HEADS // SWA_KV_HEADS
SWA_WIDTH = SWA_Q_HEADS * HEAD_DIM
SWA_KV_WIDTH = SWA_KV_HEADS * HEAD_DIM
CONV_CH = D_MODEL - RET_WIDTH - SWA_WIDTH
CONV_K = 3
MIX_WIDTH = RET_WIDTH + SWA_WIDTH + CONV_CH
IN_WIDTH = 4 * RET_WIDTH + SWA_WIDTH + 2 * SWA_KV_WIDTH + 3 * CONV_CH
FFN_HIDDEN = -(-8 * D_MODEL // (3 * 256)) * 256
WINDOW = 128
SWA_BLOCK = 128
RET_CHUNK = 128
ROPE_THETA = 10000.0
EPS = 1e-6
NEG_INF = -1e30

kernel_name = "hymba_style_retention_swa_shortconv_hybrid"


def _rms_norm(x, g):
    xf = x.astype(jnp.float32)
    y = xf * lax.rsqrt(jnp.mean(xf * xf, axis=-1, keepdims=True) + EPS)
    return (y * g).astype(x.dtype)


def _rope_tables(seq):
    inv = 1.0 / (ROPE_THETA ** (jnp.arange(0, HEAD_DIM, 2, dtype=jnp.float32) / HEAD_DIM))
    ang = jnp.arange(seq, dtype=jnp.float32)[:, None] * inv[None, :]
    return jnp.cos(ang)[:, None, :], jnp.sin(ang)[:, None, :]


def _rope(x, cos, sin):
    x1, x2 = jnp.split(x, 2, axis=-1)
    return jnp.concatenate([x1 * cos - x2 * sin, x2 * cos + x1 * sin], axis=-1)


def _retention(q, k, v, g, gn_gain, cos, sin):
    b, s, _ = q.shape
    n = s // RET_CHUNK
    q = _rope(q.reshape(b, s, RET_HEADS, HEAD_DIM), cos, sin)
    k = _rope(k.reshape(b, s, RET_HEADS, HEAD_DIM), cos, sin) * (HEAD_DIM ** -0.5)
    v = v.reshape(b, s, RET_HEADS, HEAD_DIM)
    qc = q.reshape(b, n, RET_CHUNK, RET_HEADS, HEAD_DIM)
    kc = k.reshape(b, n, RET_CHUNK, RET_HEADS, HEAD_DIM)
    vc = v.reshape(b, n, RET_CHUNK, RET_HEADS, HEAD_DIM)
    log_gamma = jnp.log(1.0 - 2.0 ** (-5.0 - jnp.arange(RET_HEADS, dtype=jnp.float32)))
    idx = jnp.arange(RET_CHUNK, dtype=jnp.float32)
    rel = idx[:, None] - idx[None, :]
    intra_decay = jnp.where(rel >= 0, jnp.exp(log_gamma[:, None, None] * jnp.maximum(rel, 0.0)), 0.0)
    scores = jnp.einsum('bnqhd,bnkhd->bnhqk', qc, kc) * intra_decay
    inner = jnp.einsum('bnhqk,bnkhe->bnqhe', scores, vc)
    k_decay = jnp.exp(log_gamma[:, None] * (RET_CHUNK - 1.0 - idx)[None, :])
    chunk_kv = jnp.einsum('bnkhd,hk,bnkhe->bnhde', kc, k_decay, vc).astype(jnp.float32)
    chunk_decay = jnp.exp(log_gamma * RET_CHUNK)[None, :, None, None]

    def step(state, kv_n):
        return state * chunk_decay + kv_n, state

    init = jnp.zeros((b, RET_HEADS, HEAD_DIM, HEAD_DIM), jnp.float32)
    _, prev = lax.scan(step, init, jnp.moveaxis(chunk_kv, 1, 0))
    prev = jnp.moveaxis(prev, 0, 1)
    q_decay = jnp.exp(log_gamma[:, None] * (idx + 1.0)[None, :])
    cross = jnp.einsum('bnqhd,bnhde,hq->bnqhe', qc, prev, q_decay)
    o = (inner + cross).astype(jnp.float32)
    mu = jnp.mean(o, axis=-1, keepdims=True)
    var = jnp.mean(jnp.square(o - mu), axis=-1, keepdims=True)
    o = ((o - mu) * lax.rsqrt(var + EPS)).reshape(b, s, RET_WIDTH) * gn_gain
    return (o * jax.nn.silu(g.astype(jnp.float32))).astype(g.dtype)


def _swa_sink_attention(q, k, v, q_norm, k_norm, sinks, cos, sin):
    b, s, _ = q.shape
    nb = s // SWA_BLOCK
    q = _rope(_rms_norm(q.reshape(b, s, SWA_Q_HEADS, HEAD_DIM), q_norm), cos, sin)
    k = _rope(_rms_norm(k.reshape(b, s, SWA_KV_HEADS, HEAD_DIM), k_norm), cos, sin)
    v = v.reshape(b, s, SWA_KV_HEADS, HEAD_DIM)
    qb = q.reshape(b, nb, SWA_BLOCK, SWA_KV_HEADS, SWA_GROUP, HEAD_DIM)
    kb = k.reshape(b, nb, SWA_BLOCK, SWA_KV_HEADS, HEAD_DIM)
    vb = v.reshape(b, nb, SWA_BLOCK, SWA_KV_HEADS, HEAD_DIM)
    kw = jnp.concatenate([jnp.concatenate([jnp.zeros_like(kb[:, :1]), kb[:, :-1]], axis=1), kb], axis=2)
    vw = jnp.concatenate([jnp.concatenate([jnp.zeros_like(vb[:, :1]), vb[:, :-1]], axis=1), vb], axis=2)
    sc = jnp.einsum('bnqhgd,bnkhd->bnhgqk', qb, kw).astype(jnp.float32) * (HEAD_DIM ** -0.5)
    qpos = jnp.arange(SWA_BLOCK) + SWA_BLOCK
    kpos = jnp.arange(2 * SWA_BLOCK)
    diff = qpos[:, None] - kpos[None, :]
    band = (diff >= 0) & (diff < WINDOW)
    first_ok = (jnp.arange(nb)[:, None, None] > 0) | (kpos[None, None, :] >= SWA_BLOCK)
    mask = band[None] & first_ok
    sc = jnp.where(mask[None, :, None, None], sc, NEG_INF)
    sink = sinks.astype(jnp.float32).reshape(SWA_KV_HEADS, SWA_GROUP)[None, None, :, :, None, None]
    m = jnp.maximum(jnp.max(sc, axis=-1, keepdims=True), sink)
    p = jnp.exp(sc - m)
    p = p / (jnp.sum(p, axis=-1, keepdims=True) + jnp.exp(sink - m))
    o = jnp.einsum('bnhgqk,bnkhd->bnqhgd', p.astype(vw.dtype), vw)
    return o.reshape(b, s, SWA_WIDTH)


def _short_conv(gb, gc, u, conv_w, conv_b):
    s = u.shape[1]
    z = gc * u
    zp = jnp.pad(z, ((0, 0), (CONV_K - 1, 0), (0, 0)))
    y = zp[:, 0:s] * conv_w[0] + zp[:, 1:s + 1] * conv_w[1] + zp[:, 2:s + 2] * conv_w[2] + conv_b
    return gb * y


def _layer(x, c, w_ada, b_ada, g_mix, w_in, conv_w, conv_b, q_norm, k_norm, sinks, ret_gn, w_out,
           g_ffn, w_gu, w_down, cos, sin):
    mod = jnp.einsum('bd,de->be', jax.nn.silu(c), w_ada) + b_ada
    sh1, sc1, ga1, sh2, sc2, ga2 = [m[:, None, :] for m in jnp.split(mod, 6, axis=-1)]
    h = _rms_norm(x, g_mix) * (1.0 + sc1) + sh1
    proj = jnp.einsum('bsd,de->bse', h, w_in)
    cuts = [RET_WIDTH, 2 * RET_WIDTH, 3 * RET_WIDTH, 4 * RET_WIDTH,
            4 * RET_WIDTH + SWA_WIDTH,
            4 * RET_WIDTH + SWA_WIDTH + SWA_KV_WIDTH,
            4 * RET_WIDTH + SWA_WIDTH + 2 * SWA_KV_WIDTH,
            4 * RET_WIDTH + SWA_WIDTH + 2 * SWA_KV_WIDTH + CONV_CH,
            4 * RET_WIDTH + SWA_WIDTH + 2 * SWA_KV_WIDTH + 2 * CONV_CH]
    rq, rk, rv, rg, aq, ak, av, cb, cc, cu = jnp.split(proj, cuts, axis=-1)
    o_ret = _retention(rq, rk, rv, rg, ret_gn, cos, sin)
    o_swa = _swa_sink_attention(aq, ak, av, q_norm, k_norm, sinks, cos, sin)
    o_conv = _short_conv(cb, cc, cu, conv_w, conv_b)
    mix = jnp.concatenate([o_ret, o_swa, o_conv], axis=-1)
    x = x + ga1 * jnp.einsum('bse,ed->bsd', mix, w_out)
    h = _rms_norm(x, g_ffn) * (1.0 + sc2) + sh2
    gt, up = jnp.split(jnp.einsum('bsd,df->bsf', h, w_gu), 2, axis=-1)
    x = x + ga2 * jnp.einsum('bsf,fd->bsd', jax.nn.silu(gt) * up, w_down)
    return x


def setup_inputs(seed: int = 0) -> dict:
    key = jax.random.key(seed)
    ks = jax.random.split(key, 18)

    def nrm(k, shape, scale):
        return jax.random.normal(k, shape, jnp.float32) * scale

    L, D = DEPTH, D_MODEL
    return {
        'x': nrm(ks[0], (BATCH, SEQ, D), 1.0),
        'c': nrm(ks[1], (BATCH, D), 1.0),
        'w_ada': nrm(ks[2], (L, D, 6 * D), 0.5 * D ** -0.5),
        'b_ada': nrm(ks[3], (L, 6 * D), 0.01),
        'g_mix': 1.0 + nrm(ks[4], (L, D), 0.02),
        'w_in': nrm(ks[5], (L, D, IN_WIDTH), D ** -0.5),
        'conv_w': nrm(ks[6], (L, CONV_K, CONV_CH), CONV_K ** -0.5),
        'conv_b': nrm(ks[7], (L, CONV_CH), 0.01),
        'q_norm': 1.0 + nrm(ks[8], (L, HEAD_DIM), 0.02),
        'k_norm': 1.0 + nrm(ks[9], (L, HEAD_DIM), 0.02),
        'sinks': nrm(ks[10], (L, SWA_Q_HEADS), 1.0),
        'ret_gn': 1.0 + nrm(ks[11], (L, RET_WIDTH), 0.02),
        'w_out': nrm(ks[12], (L, MIX_WIDTH, D), MIX_WIDTH ** -0.5),
        'g_ffn': 1.0 + nrm(ks[13], (L, D), 0.02),
        'w_gu': nrm(ks[14], (L, D, 2 * FFN_HIDDEN), D ** -0.5),
        'w_down': nrm(ks[15], (L, FFN_HIDDEN, D), FFN_HIDDEN ** -0.5),
    }


def reference(x, c, w_ada, b_ada, g_mix, w_in, conv_w, conv_b, q_norm, k_norm, sinks, ret_gn, w_out,
              g_ffn, w_gu, w_down):
    cos, sin = _rope_tables(x.shape[1])
    for l in range(DEPTH):
        x = _layer(x, c, w_ada[l], b_ada[l], g_mix[l], w_in[l], conv_w[l], conv_b[l], q_norm[l],
                   k_norm[l], sinks[l], ret_gn[l], w_out[l], g_ffn[l], w_gu[l], w_down[l], cos, sin)
    return x
```

```cpp
#include <hip/hip_runtime.h>
#include <hip/hip_cooperative_groups.h>
#include <cstdio>
#include <cstdint>
namespace cg = cooperative_groups;
namespace pg8 {
#define PG8_LAS __attribute__((address_space(3)))
typedef unsigned short bf16_t;
typedef short bf16x8 __attribute__((ext_vector_type(8)));
typedef float f32x4 __attribute__((ext_vector_type(4)));
typedef unsigned u32x4 __attribute__((ext_vector_type(4)));
constexpr int BM = 256, BK = 64, HALF = 128, HTB = HALF * BK * 2  , STAGE_BYTES = 8 * HTB, NXCD = 8, WGM = 8;

__host__ __device__ __forceinline__ int lds_byte(int r, int c) { const int st = (r >> 4) * 2 + (c >> 5), rr = r & 15, cc = c & 31, ob = rr * 64 + cc * 2; return st * 1024 + (ob ^ (((ob >> 9) & 1) << 5)); }
__host__ __device__ __forceinline__ void stage_rc(int b, int& R, int& C) { const int st = b / 1024, sb = b % 1024, swz = sb ^ (((sb >> 9) & 1) << 5); R = (st >> 1) * 16 + swz / 64; C = (st & 1) * 32 + (swz % 64) / 2; }
__host__ __device__ __forceinline__ int perm32(int rho) { const int n = rho >> 4, i = rho & 15; return 8 * (i >> 2) + 4 * n + (i & 3); }

struct Unit { int pm, pn; };
struct Gemm { const bf16_t* A; const bf16_t* Bt; int M, N, K; };

struct StaticOrder {
    int nM, nN, nwg, G, c;
    __host__ __device__ void init(int M, int N, int G_, int c_) { nM = M / BM; nN = N / BM; nwg = nM * nN; G = G_; c = c_; }
    __host__ __device__ bool next(int i, Unit& u) const {
        const long L = (long)i * G + c; if (L >= nwg) return false;
        int wgid = (int)L; { const int q = nwg / NXCD, r = nwg % NXCD, xcd = wgid % NXCD, off = wgid / NXCD; wgid = (xcd < r ? xcd * (q + 1) : r * (q + 1) + (xcd - r) * q) + off; }
        const int nig = WGM * nN, gid = wgid / nig, fm = gid * WGM, gsz = (nM - fm) < WGM ? (nM - fm) : WGM;
        u.pm = fm + ((wgid % nig) % gsz); u.pn = (wgid % nig) / gsz; return true;
    }
    __device__ __forceinline__ void a_ready(const Unit&) const {}
    __device__ __forceinline__ void done(const Unit&) const {}
};
__device__ __forceinline__ unsigned cvt_pk_bf16(float lo, float hi) { unsigned r; asm volatile("v_cvt_pk_bf16_f32 %0, %1, %2" : "=v"(r) : "v"(lo), "v"(hi)); return r; }
template <class Epi, class Sched, bool ALIGN_EPI = false, bool SP2 = false, bool ATILED = false, bool BTILED = false>
__device__ __forceinline__ void gemm_phase(PG8_LAS unsigned char* lds, const Gemm g, const Sched& S, const Epi& E, const int tid) {
    const int wid = __builtin_amdgcn_readfirstlane(tid >> 6), lane = tid & 63, wr = wid >> 2, wc = wid & 3, fr = lane & 15, fq = lane >> 4;
    const int K = g.K, nt = K / BK;
    unsigned voffA[2], voffB[2];
#pragma unroll
    for (int i = 0; i < 2; ++i) { int R, C; stage_rc(tid * 16 + i * 8192, R, C); const int Rb = Epi::PERM ? ((R & ~31) + perm32(R & 31)) : R;
        voffA[i] = (unsigned)(R * (ATILED ? BK : K) + C) * 2u; voffB[i] = (unsigned)(Rb * (BTILED ? BK : K) + C) * 2u; }
    const size_t kstep = (size_t)(BK * 2);
    const size_t hstep = (size_t)HALF * K * 2;
    const size_t tstep = 2 * hstep;
    const size_t kstepA = ATILED ? (size_t)BM * BK * 2 : kstep, hstepA = ATILED ? (size_t)HALF * BK * 2 : hstep, tstepA = ATILED ? (size_t)(K / BK) * BM * BK * 2 : tstep;
    const size_t kstepB = BTILED ? (size_t)BM * BK * 2 : kstep, hstepB = BTILED ? (size_t)HALF * BK * 2 : hstep, tstepB = BTILED ? (size_t)(K / BK) * BM * BK * 2 : tstep;
    const unsigned ldsw = (unsigned)wid * 1024u;
    const int aoff = lds_byte(wr * 64 + fr, fq * 8), boff = lds_byte(wc * 32 + fr, fq * 8);
#define PG8_SA(b, h) (((b) * 2 + (h)) * HTB)
#define PG8_SB(b, h) ((4 + (b) * 2 + (h)) * HTB)
#define PG8_STAGE(bufoff, gbase, voff) do { _Pragma("unroll") for (int _i = 0; _i < 2; ++_i) \
        __builtin_amdgcn_global_load_lds((const unsigned*)((const char*)(gbase) + (voff)[_i]), (PG8_LAS unsigned*)(lds + (bufoff) + ldsw + _i * 8192), 16, 0, 0); } while (0)
#define PG8_LDA(dst, b, h) do { _Pragma("unroll") for (int m = 0; m < 4; ++m) _Pragma("unroll") for (int k = 0; k < 2; ++k) dst[m][k] = *(const PG8_LAS bf16x8*)(lds + PG8_SA(b, h) + aoff + m * 2048 + k * 1024); } while (0)
#define PG8_LDB(dst, b, h) do { _Pragma("unroll") for (int n = 0; n < 2; ++n) _Pragma("unroll") for (int k = 0; k < 2; ++k) dst[n][k] = *(const PG8_LAS bf16x8*)(lds + PG8_SB(b, h) + boff + n * 2048 + k * 1024); } while (0)
#define PG8_MMA(ai, bj, At, Bt) do { __builtin_amdgcn_s_setprio(1); _Pragma("unroll") for (int m = 0; m < 4; ++m) _Pragma("unroll") for (int n = 0; n < 2; ++n) _Pragma("unroll") for (int k = 0; k < 2; ++k) \
        acc[ai][bj][m][n] = __builtin_amdgcn_mfma_f32_16x16x32_bf16(Bt[n][k], At[m][k], acc[ai][bj][m][n], 0, 0, 0); __builtin_amdgcn_s_setprio(0); } while (0)
#define PG8_WAIT_V(n) asm volatile("s_waitcnt vmcnt(" #n ")" ::: "memory")
#define PG8_WAIT_L(n) asm volatile("s_waitcnt lgkmcnt(" #n ")" ::: "memory")
#define PG8_BAR __builtin_amdgcn_s_barrier()
#define PG8_SCHED __builtin_amdgcn_sched_barrier(0)
    Unit cur, nxt; int ui = 0;
    if (!S.next(0, cur)) return;
    f32x4 acc[2][2][4][2];
#pragma unroll
    for (int a = 0; a < 2; ++a)
#pragma unroll
        for (int b = 0; b < 2; ++b)
#pragma unroll
            for (int m = 0; m < 4; ++m)
#pragma unroll
                for (int n = 0; n < 2; ++n) acc[a][b][m][n] = (f32x4){0.f, 0.f, 0.f, 0.f};
    bf16x8 At[4][2], B0[2][2], B1[2][2];
    const char* cA = (const char*)g.A + (size_t)cur.pm * tstepA; const char* cB = (const char*)g.Bt + (size_t)cur.pn * tstepB;
    S.a_ready(cur);
    if constexpr (SP2) {
        PG8_STAGE(PG8_SB(0, 0), cB, voffB); PG8_STAGE(PG8_SB(0, 1), cB + hstepB, voffB); PG8_STAGE(PG8_SA(0, 0), cA, voffA); PG8_STAGE(PG8_SA(0, 1), cA + hstepA, voffA);
        if (wr == 1) PG8_BAR;
        PG8_WAIT_V(2); PG8_BAR;
        PG8_STAGE(PG8_SB(1, 0), cB + kstepB, voffB); PG8_STAGE(PG8_SA(1, 0), cA + kstepA, voffA); PG8_STAGE(PG8_SB(1, 1), cB + hstepB + kstepB, voffB);
        PG8_WAIT_V(6); PG8_BAR;
    } else {
        PG8_STAGE(PG8_SB(0, 0), cB, voffB); PG8_STAGE(PG8_SA(0, 0), cA, voffA); PG8_STAGE(PG8_SB(0, 1), cB + hstepB, voffB); PG8_STAGE(PG8_SA(0, 1), cA + hstepA, voffA);
        if (wr == 1) PG8_BAR;
        PG8_WAIT_V(4); PG8_BAR;
        PG8_STAGE(PG8_SB(1, 0), cB + kstepB, voffB); PG8_STAGE(PG8_SA(1, 0), cA + kstepA, voffA); PG8_STAGE(PG8_SB(1, 1), cB + hstepB + kstepB, voffB);
        PG8_WAIT_V(6); PG8_BAR;
    }
    for (;;) {
        const bool has_next = S.next(ui + 1, nxt);
        const char* nA = has_next ? (const char*)g.A + (size_t)nxt.pm * tstepA : cA; const char* nB = has_next ? (const char*)g.Bt + (size_t)nxt.pn * tstepB : cB;
        for (int t = 0; t < nt; t += 2) {
            const bool last = (t == nt - 2);
            const char* a1 = cA + (size_t)(t + 1) * kstepA;
            const char* a2 = last ? nA : cA + (size_t)(t + 2) * kstepA; const char* b2 = last ? nB : cB + (size_t)(t + 2) * kstepB;
            const char* a3 = a2 + kstepA; const char* b3 = b2 + kstepB;
            if (last && has_next) S.a_ready(nxt);
            if constexpr (SP2) {
            PG8_LDB(B0, 0, 0); PG8_LDB(B1, 0, 1); PG8_SCHED; PG8_LDA(At, 0, 0); PG8_STAGE(PG8_SA(1, 1), a1 + hstepA, voffA);
            PG8_WAIT_V(8); PG8_WAIT_L(0); PG8_BAR; PG8_MMA(0, 0, At, B0); PG8_MMA(0, 1, At, B1); PG8_BAR; PG8_SCHED;
            PG8_LDA(At, 0, 1); PG8_STAGE(PG8_SB(0, 0), b2, voffB); PG8_STAGE(PG8_SB(0, 1), b2 + hstepB, voffB); PG8_STAGE(PG8_SA(0, 0), a2, voffA);
            PG8_WAIT_V(8); PG8_WAIT_L(0); PG8_BAR; PG8_MMA(1, 0, At, B0); PG8_MMA(1, 1, At, B1); PG8_BAR; PG8_SCHED;
            PG8_LDB(B0, 1, 0); PG8_LDB(B1, 1, 1); PG8_SCHED; PG8_LDA(At, 1, 0); PG8_STAGE(PG8_SA(0, 1), a2 + hstepA, voffA);
            PG8_WAIT_V(8); PG8_WAIT_L(0); PG8_BAR; PG8_MMA(0, 0, At, B0); PG8_MMA(0, 1, At, B1); PG8_BAR; PG8_SCHED;
            PG8_LDA(At, 1, 1); PG8_STAGE(PG8_SB(1, 0), b3, voffB); PG8_STAGE(PG8_SB(1, 1), b3 + hstepB, voffB); PG8_STAGE(PG8_SA(1, 0), a3, voffA);
            PG8_WAIT_V(8); PG8_WAIT_L(0); PG8_BAR; PG8_MMA(1, 0, At, B0); PG8_MMA(1, 1, At, B1); PG8_BAR; PG8_SCHED;
            } else {
            PG8_LDB(B0, 0, 0); PG8_SCHED; PG8_LDA(At, 0, 0); PG8_STAGE(PG8_SA(1, 1), a1 + hstepA, voffA);
            PG8_WAIT_L(8); PG8_BAR; PG8_WAIT_L(0); PG8_MMA(0, 0, At, B0); PG8_BAR; PG8_SCHED;
            PG8_LDB(B1, 0, 1); PG8_STAGE(PG8_SB(0, 0), b2, voffB);
            PG8_BAR; PG8_WAIT_L(0); PG8_MMA(0, 1, At, B1); PG8_BAR;
            PG8_LDA(At, 0, 1); PG8_STAGE(PG8_SA(0, 0), a2, voffA);
            PG8_BAR; PG8_WAIT_L(0); PG8_MMA(1, 0, At, B0); PG8_BAR; PG8_SCHED;
            PG8_STAGE(PG8_SB(0, 1), b2 + hstepB, voffB);
            PG8_WAIT_V(6); PG8_BAR; PG8_MMA(1, 1, At, B1); PG8_BAR;
            PG8_LDB(B0, 1, 0); PG8_SCHED; PG8_LDA(At, 1, 0); PG8_STAGE(PG8_SA(0, 1), a2 + hstepA, voffA);
            PG8_WAIT_L(8); PG8_BAR; PG8_WAIT_L(0); PG8_MMA(0, 0, At, B0); PG8_BAR; PG8_SCHED;
            PG8_LDB(B1, 1, 1); PG8_STAGE(PG8_SB(1, 0), b3, voffB);
            PG8_BAR; PG8_WAIT_L(0); PG8_MMA(0, 1, At, B1); PG8_BAR;
            PG8_LDA(At, 1, 1); PG8_STAGE(PG8_SA(1, 0), a3, voffA);
            PG8_BAR; PG8_WAIT_L(0); PG8_MMA(1, 0, At, B0); PG8_BAR; PG8_SCHED;
            PG8_STAGE(PG8_SB(1, 1), b3 + hstepB, voffB);
            PG8_WAIT_V(6); PG8_BAR; PG8_MMA(1, 1, At, B1); PG8_BAR;
            }
        }
        if constexpr (ALIGN_EPI) { if (wr == 0) PG8_BAR; }
        if constexpr (!Epi::AFTER_DRAIN) { E(acc, cur, wr, wc, fr, fq); S.done(cur); }
        if (!has_next) break;
#pragma unroll
        for (int a = 0; a < 2; ++a)
#pragma unroll
            for (int b = 0; b < 2; ++b)
#pragma unroll
                for (int m = 0; m < 4; ++m)
#pragma unroll
                    for (int n = 0; n < 2; ++n) acc[a][b][m][n] = (f32x4){0.f, 0.f, 0.f, 0.f};
        cur = nxt; cA = nA; cB = nB; ++ui;
        if constexpr (ALIGN_EPI) { if (wr == 1) PG8_BAR; }
    }
    PG8_WAIT_V(0);
    if constexpr (!ALIGN_EPI) { if (wr == 0) PG8_BAR; }
    PG8_BAR;
    if constexpr (Epi::AFTER_DRAIN) { E.fused(acc, cur, wr, wc, fr, fq, lds, wid, lane); S.done(cur); }
#undef PG8_SA
#undef PG8_SB
#undef PG8_STAGE
#undef PG8_LDA
#undef PG8_LDB
#undef PG8_MMA
#undef PG8_WAIT_V
#undef PG8_WAIT_L
#undef PG8_BAR
#undef PG8_SCHED
}
}
#define LAS __attribute__((address_space(3)))
#define GAS __attribute__((address_space(1)))
#define XB_TMO      128
#define XB_XCNT(j)  (256  + 64 * (j))
#define XB_XSUB(j)  (1280 + 64 * (j))
#define XB_XGEN(j)  (2304 + 64 * (j))
#define XB_TOP      3328
#define XB_TOPGEN   3392
#define XCD_BAR_WORDS 3456
#define XB_SPIN_CAP (1u << 18)

__device__ __forceinline__ unsigned xb_ld(unsigned* p)              { return __hip_atomic_load(p, __ATOMIC_RELAXED, __HIP_MEMORY_SCOPE_AGENT); }
__device__ __forceinline__ unsigned xb_add(unsigned* p, unsigned v) { return __hip_atomic_fetch_add(p, v, __ATOMIC_RELAXED, __HIP_MEMORY_SCOPE_AGENT); }
__device__ __forceinline__ unsigned xb_xcc_id() { return (unsigned)__builtin_amdgcn_s_getreg((3 << 11) | 20) & 0xFu; }
#define XB_SPIN(cond, bar) do { unsigned _sp = 0; while (cond) { __builtin_amdgcn_s_sleep(1); \
    if ((++_sp & 255u) == 0u) { if (xb_ld(&(bar)[XB_TMO])) break; if (_sp > XB_SPIN_CAP) { atomicAdd(&(bar)[XB_TMO], 1u); break; } } } } while (0)

struct XcdBarrier {
    unsigned* bar; unsigned x;
    volatile LAS unsigned* st;
};

__device__ __forceinline__ XcdBarrier xcd_barrier_post(unsigned* bar, volatile LAS unsigned* st) {
    XcdBarrier b; b.bar = bar; b.x = xb_xcc_id(); b.st = st;
    if (threadIdx.x == 0) (void)xb_add(&bar[XB_XCNT(b.x)], 1u);
    return b;
}
__device__ __forceinline__ void xcd_barrier_complete(unsigned* bar, unsigned x, unsigned& nloc, unsigned& nx) {
    const unsigned G = gridDim.x * gridDim.y * gridDim.z;
    unsigned sum, cnt, mine, sp = 0u;
    for (;;) {
        sum = 0u; cnt = 0u; mine = 0u;
#pragma unroll
        for (unsigned j = 0; j < 16; ++j) { const unsigned c = xb_ld(&bar[XB_XCNT(j)]); sum += c; cnt += (c > 0u) ? 1u : 0u; mine = (j == x) ? c : mine; }
        if (sum == G) break;
        __builtin_amdgcn_s_sleep(1);
        if ((++sp & 255u) == 0u) { if (xb_ld(&bar[XB_TMO])) break; if (sp > XB_SPIN_CAP) { atomicAdd(&bar[XB_TMO], 1u); break; } }
    }
    nloc = mine > 0u ? mine : 1u; nx = cnt > 0u ? cnt : 1u;
}

__device__ __forceinline__ void xcd_barrier(const XcdBarrier& b, const int tid) {
    asm volatile("s_waitcnt vmcnt(0)" ::: "memory");
    __syncthreads();
    if (tid == 0) {
        unsigned* bar = b.bar;
        __builtin_amdgcn_s_waitcnt(0);
        unsigned nloc = b.st[0], nx = b.st[1];
        if (nloc == 0u) { xcd_barrier_complete(bar, b.x, nloc, nx); b.st[0] = nloc; b.st[1] = nx; }
        const unsigned old = xb_add(&bar[XB_XSUB(b.x)], 1u);
        const unsigned gen = old / nloc;
        if (old + 1u == (gen + 1u) * nloc) {
            __builtin_amdgcn_fence(__ATOMIC_RELEASE, "agent");
            asm volatile("s_waitcnt vmcnt(0)" ::: "memory");
            const unsigned og = xb_add(&bar[XB_TOP], 1u);
            const unsigned tg = og / nx;
            if (og + 1u == (tg + 1u) * nx) xb_add(&bar[XB_TOPGEN], 1u);
            else XB_SPIN(xb_ld(&bar[XB_TOPGEN]) == tg, bar);
            __builtin_amdgcn_fence(__ATOMIC_ACQUIRE, "agent");
            xb_add(&bar[XB_XGEN(b.x)], 1u);
            asm volatile("s_waitcnt vmcnt(0)" ::: "memory");
        } else {
            XB_SPIN(xb_ld(&bar[XB_XGEN(b.x)]) == gen, bar);
            __builtin_amdgcn_fence(__ATOMIC_ACQUIRE, "agent");
            asm volatile("s_waitcnt vmcnt(0)" ::: "memory");
        }
    }
    __syncthreads();
}


typedef unsigned short bf16_t;
typedef short bf16x8 __attribute__((ext_vector_type(8)));
typedef float f32x4 __attribute__((ext_vector_type(4)));
typedef unsigned u32x4 __attribute__((ext_vector_type(4)));
typedef unsigned u32x2 __attribute__((ext_vector_type(2)));
typedef float f32x2 __attribute__((ext_vector_type(2)));
using pg8::cvt_pk_bf16;

constexpr int SEQ = 16384, DM = 1024, NL = 4, INW = 2944, INP = 3072, FH = 2816, GU = 5632;
constexpr int C_RQ = 0, C_RK = 384, C_RV = 768, C_RG = 1152, C_AQ = 1536, C_AK = 1920, C_AV = 2048, C_CB = 2176, C_CC = 2432, C_CU = 2688;
constexpr int MIX_SWA = 384, MIX_CONV = 768;
constexpr float EPSF = 1e-6f;
constexpr size_t MiB = 1u << 20;
constexpr size_t WS_WIN = 0, WS_WOUT = 24 * MiB, WS_WGU = 32 * MiB, WS_WDN = 76 * MiB, WS_XG = 98 * MiB, WS_PROJ = 130 * MiB  ,
                 WS_MIX = 226 * MiB, WS_KVT = 258 * MiB, WS_ST = 270 * MiB, WS_COS = 276 * MiB, WS_SIN = 278 * MiB, WS_MODP = 130 * MiB  ,
                 WS_MOD = 283 * MiB, WS_SHWIN = 283 * MiB + 256 * 1024, WS_SHWGU = 283 * MiB + 512 * 1024, WS_SSQ = 284 * MiB, WS_SHP = 280 * MiB  , WS_GP = 283 * MiB + 128 * 1024  , WS_CTL = 285 * MiB, WS_XR = 286 * MiB  , WS_END = 318 * MiB;
constexpr size_t CTL_BYTES = 16384;
constexpr int MISC_OFF = 131072 + 512;
constexpr int LDS_BYTES = 147456;
constexpr int NPRO = 4, NPH = NPRO + 7 * NL;

__device__ __forceinline__ size_t TX(int row, int col) { return ((((size_t)(row >> 8) * 16 + (col >> 6)) * 256 + (row & 255)) << 6) + (col & 63); }
__device__ __forceinline__ size_t PJ(int row, int col) { return ((size_t)(col >> 6) * SEQ + row) * 64 + (col & 63); }
__device__ __forceinline__ float bf2f(unsigned b) { return __uint_as_float(b << 16); }
__device__ __forceinline__ float wave_sum(float v) {
#pragma unroll
    for (int o = 1; o < 64; o <<= 1) v += __shfl_xor(v, o);
    return v;
}
__device__ __forceinline__ float silu_f(float v) { return v * __builtin_amdgcn_rcpf(1.f + __expf(-v)); }
__device__ __forceinline__ float lg2_gamma(int h) { return log2f(1.0f - __builtin_amdgcn_exp2f(-5.0f - (float)h)); }
#define LDS_WAIT() asm volatile("s_waitcnt lgkmcnt(0)" ::: "memory")


struct EpiProj {
    static constexpr bool PERM = true, AFTER_DRAIN = false;
    GAS bf16_t* proj; const GAS unsigned* ssq; const GAS float* shW; const GAS unsigned* csT; const GAS float* qn; const GAS float* kn;
    __device__ __forceinline__ void operator()(const f32x4 (&acc)[2][2][4][2], const pg8::Unit& u, int wr, int wc, int fr, int fq) const {
        const int slot = 4 * u.pn + wc;
        if (slot >= 46) return;
        int type = 2;
        if (slot < 6) type = 0; else if (slot < 12) type = 1; else if (slot < 24) type = 2; else if (slot < 30) type = 3; else if (slot < 32) type = 4;
        const bool do_rope = type != 2, do_norm = type >= 3;
        const float oscale = (type == 1 || type == 3) ? 0.125f : 1.0f;
        const GAS float* gain = (type == 3) ? qn : kn;
        f32x4 sh[2][2], gn[2][2];
#pragma unroll
        for (int bj = 0; bj < 2; ++bj)
#pragma unroll
            for (int n = 0; n < 2; ++n) {
                sh[bj][n] = *(const GAS f32x4*)(shW + 256 * u.pn + 128 * bj + 32 * wc + 8 * fq + 4 * n);
                gn[bj][n] = do_norm ? *(const GAS f32x4*)(gain + 32 * bj + 8 * fq + 4 * n) : (f32x4){1.f, 1.f, 1.f, 1.f};
                if (do_norm) gn[bj][n] = gn[bj][n] * oscale; else sh[bj][n] = sh[bj][n] * oscale;
            }
        const int row0 = 256 * u.pm + 64 * wr + fr;
        float rs[2][4];
#pragma unroll
        for (int ai = 0; ai < 2; ++ai)
#pragma unroll
            for (int m = 0; m < 4; ++m) rs[ai][m] = (float)ssq[row0 + 128 * ai + 16 * m] * (1.0f / 1024.0f);
#pragma unroll
        for (int ai = 0; ai < 2; ++ai) {
            u32x4 cs[4][2];
            if (do_rope) {
#pragma unroll
                for (int m = 0; m < 4; ++m)
#pragma unroll
                    for (int n = 0; n < 2; ++n) cs[m][n] = *(const GAS u32x4*)(csT + (size_t)(row0 + 128 * ai + 16 * m) * 32 + 8 * fq + 4 * n);
            }
#pragma unroll
            for (int m = 0; m < 4; ++m) {
                {
                    const int row = row0 + 128 * ai + 16 * m;
                    const float rstd = __builtin_amdgcn_rsqf(rs[ai][m] * (1.0f / DM) + EPSF) * (do_norm ? 1.0f : oscale);
                    f32x4 v[2][2];
#pragma unroll
                    for (int bj = 0; bj < 2; ++bj)
#pragma unroll
                        for (int n = 0; n < 2; ++n) v[bj][n] = acc[ai][bj][m][n] * rstd + sh[bj][n];
                    if (do_norm) {
                        float s = 0.f;
#pragma unroll
                        for (int bj = 0; bj < 2; ++bj)
#pragma unroll
                            for (int n = 0; n < 2; ++n) { const f32x4 x = v[bj][n]; s += (x[0] * x[0] + x[1] * x[1]) + (x[2] * x[2] + x[3] * x[3]); }
                        s += __shfl_xor(s, 16); s += __shfl_xor(s, 32);
                        const float r = __builtin_amdgcn_rsqf(s * (1.0f / 64.0f) + EPSF);
#pragma unroll
                        for (int bj = 0; bj < 2; ++bj)
#pragma unroll
                            for (int n = 0; n < 2; ++n) v[bj][n] = v[bj][n] * r * gn[bj][n];
                    }
                    if (do_rope) {
#pragma unroll
                        for (int n = 0; n < 2; ++n) { const f32x4 lo = v[0][n], hi = v[1][n]; const u32x4 p = cs[m][n];
                            const f32x4 c4 = {__uint_as_float(p.x << 16), __uint_as_float(p.y << 16), __uint_as_float(p.z << 16), __uint_as_float(p.w << 16)};
                            const f32x4 s4 = {__uint_as_float(p.x & 0xffff0000u), __uint_as_float(p.y & 0xffff0000u), __uint_as_float(p.z & 0xffff0000u), __uint_as_float(p.w & 0xffff0000u)};
                            v[0][n] = lo * c4 - hi * s4; v[1][n] = hi * c4 + lo * s4; }
                    }
#pragma unroll
                    for (int bj = 0; bj < 2; ++bj) {
                        const f32x4 o0 = v[bj][0], o1 = v[bj][1];
                        u32x4 w; w.x = cvt_pk_bf16(o0[0], o0[1]); w.y = cvt_pk_bf16(o0[2], o0[3]); w.z = cvt_pk_bf16(o1[0], o1[1]); w.w = cvt_pk_bf16(o1[2], o1[3]);
                        *(GAS u32x4*)(proj + PJ(row, 64 * slot + 32 * bj + 8 * fq)) = w;
                    }
                }
            }
        }
    }
};
template <bool NXT> struct EpiResid {
    static constexpr bool PERM = true, AFTER_DRAIN = false;
    GAS bf16_t* xres; GAS float* fout; const GAS float* ga; GAS unsigned* ssq_out;
    __device__ __forceinline__ void operator()(const f32x4 (&acc)[2][2][4][2], const pg8::Unit& u, int wr, int wc, int fr, int fq) const {
        const int colb = 256 * u.pn + 32 * wc + 8 * fq, row0 = 256 * u.pm + 64 * wr + fr;
#pragma unroll
        for (int ai = 0; ai < 2; ++ai) {
            float ss[4] = {0.f, 0.f, 0.f, 0.f};
#pragma unroll
            for (int bj = 0; bj < 2; ++bj) {
                const int col = colb + 128 * bj;
                u32x4 xr[4]; f32x4 ga4[2];
#pragma unroll
                for (int m = 0; m < 4; ++m) xr[m] = *(const GAS u32x4*)(xres + TX(row0 + 128 * ai + 16 * m, col));
#pragma unroll
                for (int n = 0; n < 2; ++n) ga4[n] = *(const GAS f32x4*)(ga + col + 4 * n);
#pragma unroll
                for (int m = 0; m < 4; ++m) {
                    const size_t off = (size_t)(row0 + 128 * ai + 16 * m) * DM + col;
                    const f32x4 x0 = {bf2f(xr[m].x & 0xffffu), bf2f(xr[m].x >> 16), bf2f(xr[m].y & 0xffffu), bf2f(xr[m].y >> 16)};
                    const f32x4 x1 = {bf2f(xr[m].z & 0xffffu), bf2f(xr[m].z >> 16), bf2f(xr[m].w & 0xffffu), bf2f(xr[m].w >> 16)};
                    const f32x4 n0 = x0 + ga4[0] * acc[ai][bj][m][0], n1 = x1 + ga4[1] * acc[ai][bj][m][1];
                    if (NXT) {
                        u32x4 w; w.x = cvt_pk_bf16(n0[0], n0[1]); w.y = cvt_pk_bf16(n0[2], n0[3]); w.z = cvt_pk_bf16(n1[0], n1[1]); w.w = cvt_pk_bf16(n1[2], n1[3]);
                        *(GAS u32x4*)(xres + TX(row0 + 128 * ai + 16 * m, col)) = w;
                        { const f32x4 q = n0 * n0 + n1 * n1; ss[m] += (q[0] + q[1]) + (q[2] + q[3]); }
                    } else { *(GAS f32x4*)(fout + off) = n0; *(GAS f32x4*)(fout + off + 4) = n1; }
                }
            }
            if (NXT) {
#pragma unroll
                for (int m = 0; m < 4; ++m) { float s = ss[m]; s += __shfl_xor(s, 16); s += __shfl_xor(s, 32);
                    if (fq == 0) __hip_atomic_fetch_add(ssq_out + row0 + 128 * ai + 16 * m, (unsigned)(s * 1024.0f + 0.5f), __ATOMIC_RELAXED, __HIP_MEMORY_SCOPE_AGENT); }
            }
        }
    }
};
struct EpiGU {
    static constexpr bool PERM = true, AFTER_DRAIN = false;
    GAS bf16_t* act; const GAS unsigned* ssq; const GAS float* shW;
    __device__ __forceinline__ void operator()(const f32x4 (&acc)[2][2][4][2], const pg8::Unit& u, int wr, int wc, int fr, int fq) const {
        f32x4 sh[2][2];
#pragma unroll
        for (int bj = 0; bj < 2; ++bj)
#pragma unroll
            for (int n = 0; n < 2; ++n) sh[bj][n] = *(const GAS f32x4*)(shW + 256 * u.pn + 128 * bj + 32 * wc + 8 * fq + 4 * n);
        const int row0 = 256 * u.pm + 64 * wr + fr;
        float rs[2][4];
#pragma unroll
        for (int ai = 0; ai < 2; ++ai)
#pragma unroll
            for (int m = 0; m < 4; ++m) rs[ai][m] = (float)ssq[row0 + 128 * ai + 16 * m] * (1.0f / 1024.0f);
#pragma unroll
        for (int ai = 0; ai < 2; ++ai)
#pragma unroll
            for (int m = 0; m < 4; ++m) {
                const int row = row0 + 128 * ai + 16 * m;
                const float rstd = __builtin_amdgcn_rsqf(rs[ai][m] * (1.0f / DM) + EPSF);
                f32x4 o[2];
#pragma unroll
                for (int n = 0; n < 2; ++n) {
                    const f32x4 g = acc[ai][0][m][n] * rstd + sh[0][n], uu = acc[ai][1][m][n] * rstd + sh[1][n];
#pragma unroll
                    for (int h = 0; h < 2; ++h) {
                        const f32x2 g2 = {g[2 * h], g[2 * h + 1]}, u2 = {uu[2 * h], uu[2 * h + 1]};
                        const f32x2 t = g2 * (-1.4426950408889634f);
                        f32x2 e; e.x = __builtin_amdgcn_exp2f(t.x); e.y = __builtin_amdgcn_exp2f(t.y);
                        const f32x2 d = e + 1.0f;
                        f32x2 r; r.x = __builtin_amdgcn_rcpf(d.x); r.y = __builtin_amdgcn_rcpf(d.y);
                        const f32x2 p = (g2 * u2) * r;
                        o[n][2 * h] = p.x; o[n][2 * h + 1] = p.y;
                    }
                }
                u32x4 w; w.x = cvt_pk_bf16(o[0][0], o[0][1]); w.y = cvt_pk_bf16(o[0][2], o[0][3]); w.z = cvt_pk_bf16(o[1][0], o[1][1]); w.w = cvt_pk_bf16(o[1][2], o[1][3]);
                *(GAS u32x4*)(act + (((size_t)u.pm * (FH / 64) + 2 * u.pn + (wc >> 1)) * 256 + (row - 256 * u.pm)) * 64 + 32 * (wc & 1) + 8 * fq) = w;
            }
    }
};

__device__ __forceinline__ void transpose_item(const GAS float* W, int K, int N, int srccol0, GAS bf16_t* WT, int dstrow0, int k0, LAS float* scr, int lane,
                                               const GAS float* gp, const GAS float* shv, GAS float* shp) {
    const int nq = lane & 7, kr = lane >> 3;
    f32x4 v[8];
#pragma unroll
    for (int i = 0; i < 8; ++i) v[i] = (srccol0 >= 0) ? *(const GAS f32x4*)(W + (size_t)(k0 + 8 * i + kr) * N + srccol0 + 4 * nq) : (f32x4){0.f, 0.f, 0.f, 0.f};
    if (gp) {
        float gk[8], sk[8];
#pragma unroll
        for (int i = 0; i < 8; ++i) { gk[i] = gp[k0 + 8 * i + kr]; sk[i] = shv[k0 + 8 * i + kr]; }
        f32x4 ps = {0.f, 0.f, 0.f, 0.f};
#pragma unroll
        for (int i = 0; i < 8; ++i) { ps += v[i] * sk[i]; v[i] = v[i] * gk[i]; }
#pragma unroll
        for (int c = 0; c < 4; ++c) { float t = ps[c]; t += __shfl_xor(t, 8); t += __shfl_xor(t, 16); t += __shfl_xor(t, 32); ps[c] = t; }
        if (kr == 0) *(GAS f32x4*)(shp + dstrow0 + 4 * nq) = ps;
    }
#pragma unroll
    for (int i = 0; i < 8; ++i) { LAS float* d = scr + (8 * i + kr) * 33 + 4 * nq; d[0] = v[i][0]; d[1] = v[i][1]; d[2] = v[i][2]; d[3] = v[i][3]; }
    LDS_WAIT();
    const int c = lane & 7;
#pragma unroll
    for (int j = 0; j < 4; ++j) { const int n = (lane >> 3) + 8 * j; const LAS float* s = scr + (8 * c) * 33 + n;
        u32x4 o; o.x = cvt_pk_bf16(s[0 * 33], s[1 * 33]); o.y = cvt_pk_bf16(s[2 * 33], s[3 * 33]); o.z = cvt_pk_bf16(s[4 * 33], s[5 * 33]); o.w = cvt_pk_bf16(s[6 * 33], s[7 * 33]);
        const int row = dstrow0 + n;
        *(GAS u32x4*)(WT + ((((size_t)(row >> 8) * (K >> 6) + (k0 >> 6)) * 256 + (row & 255)) << 6) + 8 * c) = o; }
    LDS_WAIT();
}

struct Ptrs {
    const GAS float *x, *c, *w_ada, *b_ada, *g_mix, *w_in, *conv_w, *conv_b, *q_norm, *k_norm, *sinks, *ret_gn, *w_out, *g_ffn, *w_gu, *w_down;
    GAS float* out; GAS unsigned char* ws;
};

constexpr int SHW_N = INP + GU;
constexpr int I_IN = 16 * 96, I_OUT = 16 * 32, I_GU = 16 * 176, I_DN = 44 * 32, I_L = I_IN + I_OUT + I_GU + I_DN;
__device__ __forceinline__ void convert_item(const Ptrs& P, int l, int r, LAS float* scr, int lane) {
    GAS unsigned char* ws = P.ws;
    const GAS float* mod = (const GAS float*)(ws + WS_MOD) + l * 6144; const GAS float* gp = (const GAS float*)(ws + WS_GP) + l * 2048;
    GAS float* shp = (GAS float*)(ws + WS_SHP) + (size_t)l * 16 * SHW_N;
    if (r < I_IN) { const int kb = r / 96, nb = r % 96, n0 = 32 * nb, pn = n0 >> 8, t = n0 & 255, bj = t >> 7, wc = (t >> 5) & 3, slot = 4 * pn + wc;
        transpose_item(P.w_in + (size_t)l * DM * INW, DM, INW, slot < 46 ? 64 * slot + 32 * bj : -1, (GAS bf16_t*)(ws + WS_WIN) + (size_t)l * INP * DM, n0, 64 * kb, scr, lane,
                       gp, mod, shp + (size_t)kb * SHW_N); return; }
    r -= I_IN;
    if (r < I_OUT) { const int kb = r / 32, nb = r % 32;
        transpose_item(P.w_out + (size_t)l * DM * DM, DM, DM, 32 * nb, (GAS bf16_t*)(ws + WS_WOUT) + (size_t)l * DM * DM, 32 * nb, 64 * kb, scr, lane, nullptr, nullptr, nullptr); return; }
    r -= I_OUT;
    if (r < I_GU) { const int kb = r / 176, nb = r % 176, n0 = 32 * nb, pn = n0 >> 8, t = n0 & 255, bj = t >> 7, j = t & 127;
        transpose_item(P.w_gu + (size_t)l * DM * GU, DM, GU, bj * FH + 128 * pn + j, (GAS bf16_t*)(ws + WS_WGU) + (size_t)l * GU * DM, n0, 64 * kb, scr, lane,
                       gp + 1024, mod + 3072, shp + (size_t)kb * SHW_N + INP); return; }
    r -= I_GU;
    { const int kb = r / 32, nb = r % 32;
        transpose_item(P.w_down + (size_t)l * FH * DM, FH, DM, 32 * nb, (GAS bf16_t*)(ws + WS_WDN) + (size_t)l * DM * FH, 32 * nb, 64 * kb, scr, lane, nullptr, nullptr, nullptr); }
}
__device__ __forceinline__ void shw_reduce(GAS unsigned char* ws, int l, int gt, int NGT) {
    const GAS float* shp = (const GAS float*)(ws + WS_SHP) + (size_t)l * 16 * SHW_N;
    for (int i = gt; i < SHW_N; i += NGT) { float a = 0.f;
#pragma unroll
        for (int kb = 0; kb < 16; ++kb) a += shp[(size_t)kb * SHW_N + i];
        if (i < INP) ((GAS float*)(ws + WS_SHWIN))[l * INP + i] = a; else ((GAS float*)(ws + WS_SHWGU))[l * GU + i - INP] = a; }
}

__device__ __forceinline__ void phase_p0(const Ptrs& P, LAS unsigned char* lds, int tid, int wid, int lane, int G, int bid) {
    GAS unsigned char* ws = P.ws;
    const int gt = bid * 512 + tid, NGT = G * 512;
    GAS float* part = (GAS float*)(ws + WS_MODP);
    for (int it = gt; it < NL * 64 * 1536; it += NGT) {
        const int e4 = it % 1536, ls = it / 1536, s = ls & 63, l = ls >> 6;
        const GAS float* wp = P.w_ada + ((size_t)l * DM + 16 * s) * 6144 + 4 * e4;
        f32x4 wv[16];
#pragma unroll
        for (int k = 0; k < 16; ++k) wv[k] = *(const GAS f32x4*)(wp + (size_t)k * 6144);
        f32x4 a = {0.f, 0.f, 0.f, 0.f};
#pragma unroll
        for (int k = 0; k < 16; ++k) a += wv[k] * silu_f(P.c[16 * s + k]);
        *(GAS f32x4*)(part + (size_t)ls * 6144 + 4 * e4) = a;
    }
    GAS unsigned* csT = (GAS unsigned*)(ws + WS_COS);
    for (int it = gt; it < SEQ * 32; it += NGT) {
        const int pos = it >> 5, j = it & 31;
        const float inv = 1.0f / powf(10000.0f, (float)(2 * j) / 64.0f);
        const float ang = (float)pos * inv;
        csT[it] = cvt_pk_bf16(cosf(ang), sinf(ang));
    }
    GAS unsigned* ssq = (GAS unsigned*)(ws + WS_SSQ);
    for (int it = gt; it < 8 * SEQ; it += NGT) ssq[it] = 0u;
}

__device__ __forceinline__ void phase_p1(const Ptrs& P, int tid, int G, int bid) {
    const GAS float* part = (const GAS float*)(P.ws + WS_MODP); GAS float* mod = (GAS float*)(P.ws + WS_MOD); GAS float* gp = (GAS float*)(P.ws + WS_GP);
    for (int it = bid * 512 + tid; it < NL * 6144; it += G * 512) {
        const int l = it / 6144, e = it % 6144; float a = P.b_ada[it];
        float pv[64];
#pragma unroll
        for (int s = 0; s < 64; ++s) pv[s] = part[((size_t)l * 64 + s) * 6144 + e];
#pragma unroll
        for (int s = 0; s < 64; ++s) a += pv[s];
        mod[it] = a;
        if (e >= 1024 && e < 2048) gp[l * 2048 + e - 1024] = P.g_mix[l * DM + e - 1024] * (1.0f + a);
        if (e >= 4096 && e < 5120) gp[l * 2048 + 1024 + e - 4096] = P.g_ffn[l * DM + e - 4096] * (1.0f + a);
    }
}

__device__ __forceinline__ void phase_p2(const Ptrs& P, LAS unsigned char* lds, int wid, int lane, int G, int bid) {
    GAS unsigned char* ws = P.ws;
    const int gw = bid * 8 + wid, NGW = G * 8;
    LAS float* scr = (LAS float*)(lds + wid * 16384);
    for (int it = gw; it < I_L; it += NGW) convert_item(P, 0, it, scr, lane);
    for (int it = gw; it < SEQ / 2; it += NGW) {
        const int row0 = 2 * it;
        f32x4 xv[2][4];
#pragma unroll
        for (int q = 0; q < 2; ++q)
#pragma unroll
            for (int j = 0; j < 4; ++j) xv[q][j] = *(const GAS f32x4*)(P.x + (size_t)(row0 + q) * DM + 4 * lane + 256 * j);
#pragma unroll
        for (int q = 0; q < 2; ++q) { float s = 0.f; GAS bf16_t* xr = (GAS bf16_t*)(ws + WS_XR);
#pragma unroll
            for (int j = 0; j < 4; ++j) { const f32x4 x4 = xv[q][j]; u32x2 r; r.x = cvt_pk_bf16(x4[0], x4[1]); r.y = cvt_pk_bf16(x4[2], x4[3]); *(GAS u32x2*)(xr + TX(row0 + q, 4 * lane + 256 * j)) = r;
                s += (x4[0] * x4[0] + x4[1] * x4[1]) + (x4[2] * x4[2] + x4[3] * x4[3]); }
            s = wave_sum(s);
            if (lane == 0) ((GAS unsigned*)(ws + WS_SSQ))[row0 + q] = (unsigned)(s * 1024.0f + 0.5f); }
    }
}

__device__ __forceinline__ int tsw(int d) { return ((d >> 3) & 7) << 3; }
#define MFMA16(a, b, c) __builtin_amdgcn_mfma_f32_16x16x32_bf16(a, b, c, 0, 0, 0)
__device__ __forceinline__ bf16x8 mk8(u32x2 a, u32x2 b) { u32x4 t; t.x = a.x; t.y = a.y; t.z = b.x; t.w = b.y; return __builtin_bit_cast(bf16x8, t); }

__device__ __forceinline__ void swa_item(LAS unsigned char* lds, const GAS bf16_t* proj, GAS bf16_t* mix, const GAS float* sinks, int nb, int hk, int tid, int w, int lane) {
    constexpr int KS = 72, VS = 328;
    LAS bf16_t* Ks = (LAS bf16_t*)lds;
    LAS bf16_t* VTs = (LAS bf16_t*)(lds + 36864);
    const int t0 = nb * 128;
    const int fr = lane & 15, fq = lane >> 4, ql = 16 * w + fr, tq = t0 + ql;
    u32x4 kreg[4], vreg[4]; bf16x8 qfa[3][2];
#pragma unroll
    for (int i = 0; i < 4; ++i) { const int c = tid + 512 * i, r = c >> 3, dc = (c & 7) * 8, tok = t0 - 128 + r;
        kreg[i] = (u32x4){0u, 0u, 0u, 0u}; vreg[i] = (u32x4){0u, 0u, 0u, 0u};
        if (tok >= 0) { kreg[i] = *(const GAS u32x4*)(proj + PJ(tok, C_AK + 64 * hk + dc)); vreg[i] = *(const GAS u32x4*)(proj + PJ(tok, C_AV + 64 * hk + dc)); } }
#pragma unroll
    for (int g = 0; g < 3; ++g)
#pragma unroll
        for (int c = 0; c < 2; ++c) qfa[g][c] = *(const GAS bf16x8*)(proj + PJ(tq, C_AQ + 64 * (3 * hk + g)) + 32 * c + 8 * fq);
#pragma unroll
    for (int i = 0; i < 4; ++i) { const int c = tid + 512 * i, r = c >> 3, dc = (c & 7) * 8;
        *(LAS u32x4*)(Ks + r * KS + dc) = kreg[i];
        const u32x4 v = vreg[i]; LAS bf16_t* d = VTs + dc * VS + (r ^ tsw(dc));
        d[0 * VS] = (bf16_t)(v.x & 0xffffu); d[1 * VS] = (bf16_t)(v.x >> 16); d[2 * VS] = (bf16_t)(v.y & 0xffffu); d[3 * VS] = (bf16_t)(v.y >> 16);
        d[4 * VS] = (bf16_t)(v.z & 0xffffu); d[5 * VS] = (bf16_t)(v.z >> 16); d[6 * VS] = (bf16_t)(v.w & 0xffffu); d[7 * VS] = (bf16_t)(v.w >> 16); }
    for (int c = tid; c < 64 * 64; c += 512) { const int e = c >> 6, k = 256 + (c & 63); VTs[e * VS + k] = 0; }
    __syncthreads();
#pragma unroll
    for (int g = 0; g < 3; ++g) {
        const int hq = 3 * hk + g;
        bf16x8 qf[2]; qf[0] = qfa[g][0]; qf[1] = qfa[g][1];
        f32x4 s[9];
#pragma unroll
        for (int j = 0; j < 9; ++j) { s[j] = (f32x4){0.f, 0.f, 0.f, 0.f};
#pragma unroll
            for (int c = 0; c < 2; ++c) { const bf16x8 a = *(const LAS bf16x8*)(Ks + (16 * (w + j) + fr) * KS + 32 * c + 8 * fq); s[j] = MFMA16(a, qf[c], s[j]); } }
        const float sink = sinks[hq];
        float mx = sink;
#pragma unroll
        for (int j = 0; j < 9; ++j)
#pragma unroll
            for (int i = 0; i < 4; ++i) { const int kpos = 16 * (w + j) + 4 * fq + i;
                if (j == 0) s[j][i] = kpos > ql ? s[j][i] : -1e30f;
                if (j == 8) s[j][i] = kpos <= ql + 128 ? s[j][i] : -1e30f; }
        if (nb == 0) {
#pragma unroll
            for (int j = 0; j < 9; ++j)
#pragma unroll
                for (int i = 0; i < 4; ++i) s[j][i] = (16 * (w + j) + 4 * fq + i) >= 128 ? s[j][i] : -1e30f;
        }
#pragma unroll
        for (int j = 0; j < 9; ++j)
#pragma unroll
            for (int i = 0; i < 4; ++i) mx = fmaxf(mx, s[j][i]);
        mx = fmaxf(mx, __shfl_xor(mx, 16)); mx = fmaxf(mx, __shfl_xor(mx, 32));
        float sum = 0.f; const float nmx = -mx * 1.4426950408889634f;
#pragma unroll
        for (int j = 0; j < 9; ++j)
#pragma unroll
            for (int i = 0; i < 4; ++i) { const float p = __builtin_amdgcn_exp2f(__builtin_fmaf(s[j][i], 1.4426950408889634f, nmx)); s[j][i] = p; sum += p; }
        sum += __shfl_xor(sum, 16); sum += __shfl_xor(sum, 32);
        const float inv = __builtin_amdgcn_rcpf(sum + __expf(sink - mx));
        f32x4 o[4];
#pragma unroll
        for (int et = 0; et < 4; ++et) o[et] = (f32x4){0.f, 0.f, 0.f, 0.f};
#pragma unroll
        for (int jj = 0; jj < 5; ++jj) {
            const int j0 = 2 * jj, j1 = 2 * jj + 1;
            u32x2 plo, phi; plo.x = cvt_pk_bf16(s[j0][0], s[j0][1]); plo.y = cvt_pk_bf16(s[j0][2], s[j0][3]);
            if (j1 < 9) { phi.x = cvt_pk_bf16(s[j1 < 9 ? j1 : 0][0], s[j1 < 9 ? j1 : 0][1]); phi.y = cvt_pk_bf16(s[j1 < 9 ? j1 : 0][2], s[j1 < 9 ? j1 : 0][3]); } else { phi.x = 0u; phi.y = 0u; }
            const bf16x8 pb = mk8(plo, phi);
#pragma unroll
            for (int et = 0; et < 4; ++et) {
                const LAS bf16_t* vr = VTs + (16 * et + fr) * VS; const int sw = tsw(16 * et + fr), kc0 = 16 * (w + j0) + 4 * fq;
                const u32x2 a0 = *(const LAS u32x2*)(vr + (kc0 ^ sw)), a1 = *(const LAS u32x2*)(vr + ((kc0 + 16) ^ sw));
                o[et] = MFMA16(mk8(a0, a1), pb, o[et]);
            }
        }
#pragma unroll
        for (int et = 0; et < 4; ++et) { const f32x4 v = o[et] * inv; u32x2 wv; wv.x = cvt_pk_bf16(v[0], v[1]); wv.y = cvt_pk_bf16(v[2], v[3]);
            *(GAS u32x2*)(mix + TX(tq, MIX_SWA + 64 * hq + 16 * et + 4 * fq)) = wv; }
    }
    __syncthreads();
}

__device__ __forceinline__ void chunkkv_items3(LAS unsigned char* lds, const GAS bf16_t* proj, GAS float* kvT, int it0, int stride, int tid, int w, int lane) {
    constexpr int TS = 136, IMG = 2 * 64 * TS * 2;
    u32x4 kreg[3][2], vreg[3][2];
#pragma unroll
    for (int j = 0; j < 3; ++j) { const int it = it0 + j * stride;
        if (it < 768) { const int n = it / 6, h = it % 6;
#pragma unroll
            for (int i = 0; i < 2; ++i) { const int c = tid + 512 * i, r = c >> 3, dc = (c & 7) * 8;
                kreg[j][i] = *(const GAS u32x4*)(proj + PJ((n * 128 + r), C_RK + 64 * h + dc));
                vreg[j][i] = *(const GAS u32x4*)(proj + PJ((n * 128 + r), C_RV + 64 * h + dc)); } } }
#pragma unroll
    for (int j = 0; j < 3; ++j) { const int it = it0 + j * stride;
        if (it < 768) { const float lg2 = lg2_gamma(it % 6);
            LAS bf16_t* KTs = (LAS bf16_t*)(lds + j * IMG); LAS bf16_t* VTs = KTs + 64 * TS;
#pragma unroll
            for (int i = 0; i < 2; ++i) { const int c = tid + 512 * i, r = c >> 3, dc = (c & 7) * 8;
                const u32x4 kv = kreg[j][i], vv = vreg[j][i];
                const float wk = __builtin_amdgcn_exp2f(lg2 * (float)(127 - r));
                LAS bf16_t* dk = KTs + dc * TS + (r ^ tsw(dc)); LAS bf16_t* dv = VTs + dc * TS + (r ^ tsw(dc));
                const unsigned k01 = cvt_pk_bf16(bf2f(kv.x & 0xffffu) * wk, bf2f(kv.x >> 16) * wk), k23 = cvt_pk_bf16(bf2f(kv.y & 0xffffu) * wk, bf2f(kv.y >> 16) * wk),
                               k45 = cvt_pk_bf16(bf2f(kv.z & 0xffffu) * wk, bf2f(kv.z >> 16) * wk), k67 = cvt_pk_bf16(bf2f(kv.w & 0xffffu) * wk, bf2f(kv.w >> 16) * wk);
                dk[0 * TS] = (bf16_t)(k01 & 0xffffu); dk[1 * TS] = (bf16_t)(k01 >> 16); dk[2 * TS] = (bf16_t)(k23 & 0xffffu); dk[3 * TS] = (bf16_t)(k23 >> 16);
                dk[4 * TS] = (bf16_t)(k45 & 0xffffu); dk[5 * TS] = (bf16_t)(k45 >> 16); dk[6 * TS] = (bf16_t)(k67 & 0xffffu); dk[7 * TS] = (bf16_t)(k67 >> 16);
                dv[0 * TS] = (bf16_t)(vv.x & 0xffffu); dv[1 * TS] = (bf16_t)(vv.x >> 16); dv[2 * TS] = (bf16_t)(vv.y & 0xffffu); dv[3 * TS] = (bf16_t)(vv.y >> 16);
                dv[4 * TS] = (bf16_t)(vv.z & 0xffffu); dv[5 * TS] = (bf16_t)(vv.z >> 16); dv[6 * TS] = (bf16_t)(vv.w & 0xffffu); dv[7 * TS] = (bf16_t)(vv.w >> 16); } } }
    __syncthreads();
    const int fr = lane & 15, fq = lane >> 4, et = w >> 1;
#pragma unroll
    for (int j = 0; j < 3; ++j) { const int it = it0 + j * stride;
        if (it < 768) { const int n = it / 6, h = it % 6;
            const LAS bf16_t* KTs = (const LAS bf16_t*)(lds + j * IMG); const LAS bf16_t* VTs = KTs + 64 * TS;
#pragma unroll
            for (int dd = 0; dd < 2; ++dd) { const int dt = 2 * (w & 1) + dd;
                f32x4 acc = {0.f, 0.f, 0.f, 0.f};
#pragma unroll
                for (int kc = 0; kc < 4; ++kc) { const bf16x8 a = *(const LAS bf16x8*)(VTs + (16 * et + fr) * TS + ((32 * kc + 8 * fq) ^ tsw(16 * et + fr))), b = *(const LAS bf16x8*)(KTs + (16 * dt + fr) * TS + ((32 * kc + 8 * fq) ^ tsw(16 * dt + fr)));
                    acc = MFMA16(a, b, acc); }
                GAS float* dst = kvT + ((size_t)(n * 6 + h) * 64 + 16 * et + 4 * fq) * 64 + 16 * dt + fr;
#pragma unroll
                for (int i = 0; i < 4; ++i) dst[i * 64] = acc[i];
            } } }
    __syncthreads();
}

__device__ __forceinline__ void scan_phase(const GAS float* kvT, GAS bf16_t* st, int tid, int G, int bid) {
    for (int idx = bid * 512 + tid; idx < 24576; idx += G * 512) {
        const int h = idx >> 12; const float dec = __builtin_amdgcn_exp2f(lg2_gamma(h) * 128.0f);
        float S = 0.f;
        for (int n0 = 0; n0 < 128; n0 += 64) {
            float kv[64];
#pragma unroll
            for (int i = 0; i < 64; ++i) kv[i] = kvT[(size_t)(n0 + i) * 24576 + idx];
#pragma unroll
            for (int i = 0; i < 64; ++i) { st[(size_t)(n0 + i) * 24576 + idx] = (bf16_t)(cvt_pk_bf16(S, 0.f) & 0xffffu); S = S * dec + kv[i]; }
        }
    }
}

__device__ __forceinline__ void retout_items(LAS unsigned char* lds, const GAS bf16_t* proj, const GAS bf16_t* st, const GAS float* gnw, GAS bf16_t* mix, int q0, int qstride, int nit, int tid, int w, int lane) {
    constexpr int KS = 72, VS = 200, SS = 72;
    LAS bf16_t* Ks = (LAS bf16_t*)lds;
    LAS bf16_t* VTs = (LAS bf16_t*)(lds + 18432);
    LAS bf16_t* STs = (LAS bf16_t*)(lds + 44032);
    const int fr = lane & 15, fq = lane >> 4, ql = 16 * w + fr;
    u32x4 kreg[2], vreg[2], sreg; bf16x8 qreg[2]; u32x2 greg[4];
#define RET_LOADS(qq) do { const int n_ = (qq) / 6, h_ = (qq) % 6, t0_ = n_ * 128; \
        _Pragma("unroll") for (int i = 0; i < 2; ++i) { const int c = tid + 512 * i, r = c >> 3, dc = (c & 7) * 8; \
            kreg[i] = *(const GAS u32x4*)(proj + PJ(t0_ + r, C_RK + 64 * h_ + dc)); vreg[i] = *(const GAS u32x4*)(proj + PJ(t0_ + r, C_RV + 64 * h_ + dc)); } \
        sreg = *(const GAS u32x4*)(st + ((size_t)(n_ * 6 + h_) * 64 + (tid >> 3)) * 64 + (tid & 7) * 8); \
        _Pragma("unroll") for (int c = 0; c < 2; ++c) qreg[c] = *(const GAS bf16x8*)(proj + PJ(t0_ + ql, C_RQ + 64 * h_ + 32 * c + 8 * fq)); \
        _Pragma("unroll") for (int et = 0; et < 4; ++et) greg[et] = *(const GAS u32x2*)(proj + PJ(t0_ + ql, C_RG + 64 * h_ + 16 * et + 4 * fq)); } while (0)
    RET_LOADS(q0);
#pragma unroll 1
    for (int k = 0; k < nit; ++k) {
        const int q = q0 + k * qstride, n = q / 6, h = q % 6, t0 = n * 128, tq = t0 + ql; const float lg2 = lg2_gamma(h);
#pragma unroll
        for (int i = 0; i < 2; ++i) { const int c = tid + 512 * i, r = c >> 3, dc = (c & 7) * 8;
            *(LAS u32x4*)(Ks + r * KS + dc) = kreg[i];
            const u32x4 vv = vreg[i]; LAS bf16_t* dv = VTs + dc * VS + (r ^ tsw(dc));
            dv[0 * VS] = (bf16_t)(vv.x & 0xffffu); dv[1 * VS] = (bf16_t)(vv.x >> 16); dv[2 * VS] = (bf16_t)(vv.y & 0xffffu); dv[3 * VS] = (bf16_t)(vv.y >> 16);
            dv[4 * VS] = (bf16_t)(vv.z & 0xffffu); dv[5 * VS] = (bf16_t)(vv.z >> 16); dv[6 * VS] = (bf16_t)(vv.w & 0xffffu); dv[7 * VS] = (bf16_t)(vv.w >> 16); }
        *(LAS u32x4*)(STs + (tid >> 3) * SS + (tid & 7) * 8) = sreg;
        bf16x8 qf[2]; qf[0] = qreg[0]; qf[1] = qreg[1];
        u32x2 gvv[4];
#pragma unroll
        for (int et = 0; et < 4; ++et) gvv[et] = greg[et];
        __syncthreads();
        if (k + 1 < nit) RET_LOADS(q + qstride);
        f32x4 gnv[4];
#pragma unroll
        for (int et = 0; et < 4; ++et) gnv[et] = *(const GAS f32x4*)(gnw + 64 * h + 16 * et + 4 * fq);
        f32x4 av, avm;
#pragma unroll
        for (int i = 0; i < 4; ++i) { const int d = fr - 4 * fq - i; const float e = __builtin_amdgcn_exp2f(lg2 * (float)d); av[i] = e; avm[i] = d >= 0 ? e : 0.f; }
        f32x4 s[8];
#pragma unroll
        for (int kt = 0; kt < 8; ++kt) { s[kt] = (f32x4){0.f, 0.f, 0.f, 0.f};
            if (kt <= w) {
#pragma unroll
                for (int c = 0; c < 2; ++c) { const bf16x8 a = *(const LAS bf16x8*)(Ks + (16 * kt + fr) * KS + 32 * c + 8 * fq); s[kt] = MFMA16(a, qf[c], s[kt]); }
                if (kt == w) s[kt] = s[kt] * avm; else s[kt] = s[kt] * (av * __builtin_amdgcn_exp2f(lg2 * (float)(16 * (w - kt))));
            } }
        f32x4 o[4], cr[4];
#pragma unroll
        for (int et = 0; et < 4; ++et) { o[et] = (f32x4){0.f, 0.f, 0.f, 0.f}; cr[et] = (f32x4){0.f, 0.f, 0.f, 0.f}; }
#pragma unroll
        for (int jj = 0; jj < 4; ++jj) {
            if (2 * jj <= w) {
                u32x2 plo, phi; plo.x = cvt_pk_bf16(s[2 * jj][0], s[2 * jj][1]); plo.y = cvt_pk_bf16(s[2 * jj][2], s[2 * jj][3]);
                phi.x = cvt_pk_bf16(s[2 * jj + 1][0], s[2 * jj + 1][1]); phi.y = cvt_pk_bf16(s[2 * jj + 1][2], s[2 * jj + 1][3]);
                const bf16x8 pb = mk8(plo, phi);
#pragma unroll
                for (int et = 0; et < 4; ++et) {
                    const LAS bf16_t* vr = VTs + (16 * et + fr) * VS; const int sw = tsw(16 * et + fr), kc0 = 32 * jj + 4 * fq;
                    const u32x2 a0 = *(const LAS u32x2*)(vr + (kc0 ^ sw)), a1 = *(const LAS u32x2*)(vr + ((kc0 + 16) ^ sw));
                    o[et] = MFMA16(mk8(a0, a1), pb, o[et]);
                }
            }
        }
#pragma unroll
        for (int et = 0; et < 4; ++et)
#pragma unroll
            for (int c = 0; c < 2; ++c) { const bf16x8 a = *(const LAS bf16x8*)(STs + (16 * et + fr) * SS + 32 * c + 8 * fq); cr[et] = MFMA16(a, qf[c], cr[et]); }
        const float qd = __builtin_amdgcn_exp2f(lg2 * (float)(ql + 1));
        float s1 = 0.f;
#pragma unroll
        for (int et = 0; et < 4; ++et) { o[et] = o[et] + cr[et] * qd; s1 += (o[et][0] + o[et][1]) + (o[et][2] + o[et][3]); }
        s1 += __shfl_xor(s1, 16); s1 += __shfl_xor(s1, 32);
        const float mean = s1 * (1.0f / 64.0f);
        float s2 = 0.f;
#pragma unroll
        for (int et = 0; et < 4; ++et) { o[et] = o[et] - mean; s2 += (o[et][0] * o[et][0] + o[et][1] * o[et][1]) + (o[et][2] * o[et][2] + o[et][3] * o[et][3]); }
        s2 += __shfl_xor(s2, 16); s2 += __shfl_xor(s2, 32);
        const float rs = __builtin_amdgcn_rsqf(s2 * (1.0f / 64.0f) + EPSF);
#pragma unroll
        for (int et = 0; et < 4; ++et) {
            const int col = 64 * h + 16 * et + 4 * fq;
            const u32x2 gv = gvv[et]; const f32x4 gn = gnv[et];
            f32x4 y;
            y[0] = o[et][0] * rs * gn[0] * silu_f(bf2f(gv.x & 0xffffu)); y[1] = o[et][1] * rs * gn[1] * silu_f(bf2f(gv.x >> 16));
            y[2] = o[et][2] * rs * gn[2] * silu_f(bf2f(gv.y & 0xffffu)); y[3] = o[et][3] * rs * gn[3] * silu_f(bf2f(gv.y >> 16));
            u32x2 wv; wv.x = cvt_pk_bf16(y[0], y[1]); wv.y = cvt_pk_bf16(y[2], y[3]);
            *(GAS u32x2*)(mix + TX(tq, col)) = wv;
        }
        __syncthreads();
    }
#undef RET_LOADS
}

__device__ __forceinline__ void unpk8(const u32x4 v, f32x4& lo, f32x4& hi) {
    lo = (f32x4){__uint_as_float(v.x << 16), __uint_as_float(v.x & 0xffff0000u), __uint_as_float(v.y << 16), __uint_as_float(v.y & 0xffff0000u)};
    hi = (f32x4){__uint_as_float(v.z << 16), __uint_as_float(v.z & 0xffff0000u), __uint_as_float(v.w << 16), __uint_as_float(v.w & 0xffff0000u)};
}
__device__ __forceinline__ void conv_phase(const GAS bf16_t* proj, const GAS float* cw, const GAS float* cb_, GAS bf16_t* mix, int tid, int G, int bid) {
    for (int it0 = bid * 512 + tid; it0 < (SEQ / 4) * 32; it0 += G * 512) {
        const int it = (G == 256) ? (((512 * (bid & 7) + 16 * (bid >> 3)) << 5) + tid) : it0;
        const int t0 = (it >> 5) * 4, c8 = (it & 31) * 8;
        u32x4 ccr[6], cur[6], cbr[4];
#pragma unroll
        for (int r = 0; r < 6; ++r) { const int tt = t0 - 2 + r;
            ccr[r] = (u32x4){0u, 0u, 0u, 0u}; cur[r] = (u32x4){0u, 0u, 0u, 0u};
            if (tt >= 0) { ccr[r] = *(const GAS u32x4*)(proj + PJ(tt, C_CC + c8)); cur[r] = *(const GAS u32x4*)(proj + PJ(tt, C_CU + c8)); } }
#pragma unroll
        for (int q = 0; q < 4; ++q) cbr[q] = *(const GAS u32x4*)(proj + PJ(t0 + q, C_CB + c8));
        f32x4 w[3][2], bias[2];
#pragma unroll
        for (int d = 0; d < 3; ++d) { w[d][0] = *(const GAS f32x4*)(cw + d * 256 + c8); w[d][1] = *(const GAS f32x4*)(cw + d * 256 + c8 + 4); }
        bias[0] = *(const GAS f32x4*)(cb_ + c8); bias[1] = *(const GAS f32x4*)(cb_ + c8 + 4);
        f32x4 z[6][2];
#pragma unroll
        for (int r = 0; r < 6; ++r) { f32x4 a0, a1, b0, b1; unpk8(ccr[r], a0, a1); unpk8(cur[r], b0, b1); z[r][0] = a0 * b0; z[r][1] = a1 * b1; }
#pragma unroll
        for (int q = 0; q < 4; ++q) {
            f32x4 g0, g1; unpk8(cbr[q], g0, g1);
            const f32x4 y0 = g0 * (bias[0] + z[q][0] * w[0][0] + z[q + 1][0] * w[1][0] + z[q + 2][0] * w[2][0]);
            const f32x4 y1 = g1 * (bias[1] + z[q][1] * w[0][1] + z[q + 1][1] * w[1][1] + z[q + 2][1] * w[2][1]);
            u32x4 o; o.x = cvt_pk_bf16(y0[0], y0[1]); o.y = cvt_pk_bf16(y0[2], y0[3]); o.z = cvt_pk_bf16(y1[0], y1[1]); o.w = cvt_pk_bf16(y1[2], y1[3]);
            *(GAS u32x4*)(mix + TX(t0 + q, MIX_CONV + c8)) = o;
        }
    }
}

struct Args { const float* in[16]; float* out; unsigned char* ws; int ph_lo, ph_hi; };

__global__ void __launch_bounds__(512, 2) fwd(Args a) {
    extern __shared__ __attribute__((aligned(16))) unsigned char lds_raw[];
    LAS unsigned char* lds = (LAS unsigned char*)lds_raw;
    cg::grid_group grid = cg::this_grid();
    const int ph_lo = a.ph_lo, ph_hi = a.ph_hi;
    const int wid0 = __builtin_amdgcn_readfirstlane(threadIdx.x >> 6);
    if (threadIdx.x < 2) ((LAS unsigned*)(lds + MISC_OFF))[threadIdx.x] = 0u;
    __syncthreads();
    (void)xcd_barrier_post((unsigned*)(a.ws + WS_CTL), (volatile LAS unsigned*)(lds + MISC_OFF));
    if (ph_hi > 100000) grid.sync();
    int rep = 0; bool first = true;
#pragma unroll 1
    for (int ph = ph_lo; ph < ph_hi; ++ph) {
        int wid_s = wid0; asm volatile("" : "+s"(wid_s));
        int tid; asm volatile("v_mbcnt_lo_u32_b32 %0, -1, 0\n\tv_mbcnt_hi_u32_b32 %0, -1, %0" : "=v"(tid));
        tid += wid_s * 64;
        int G = gridDim.x; asm volatile("" : "+s"(G));
        int bid = blockIdx.x; asm volatile("" : "+s"(bid));
        GAS unsigned char* ws = (GAS unsigned char*)a.ws; asm volatile("" : "+s"(ws));
        const int wid = __builtin_amdgcn_readfirstlane(tid >> 6), lane = tid & 63;
        if (!first) { XcdBarrier xb; xb.bar = (unsigned*)((unsigned char*)ws + WS_CTL); xb.x = xb_xcc_id(); xb.st = (volatile LAS unsigned*)(lds + MISC_OFF); xcd_barrier(xb, tid); }
        first = false;
        Ptrs P;
        P.x = (const GAS float*)a.in[0]; P.c = (const GAS float*)a.in[1]; P.w_ada = (const GAS float*)a.in[2]; P.b_ada = (const GAS float*)a.in[3]; P.g_mix = (const GAS float*)a.in[4]; P.w_in = (const GAS float*)a.in[5]; P.conv_w = (const GAS float*)a.in[6]; P.conv_b = (const GAS float*)a.in[7];
        P.q_norm = (const GAS float*)a.in[8]; P.k_norm = (const GAS float*)a.in[9]; P.sinks = (const GAS float*)a.in[10]; P.ret_gn = (const GAS float*)a.in[11]; P.w_out = (const GAS float*)a.in[12]; P.g_ffn = (const GAS float*)a.in[13]; P.w_gu = (const GAS float*)a.in[14]; P.w_down = (const GAS float*)a.in[15];
        P.out = (GAS float*)a.out; P.ws = ws;
        GAS bf16_t* xres = (GAS bf16_t*)(ws + WS_XR); GAS bf16_t* proj = (GAS bf16_t*)(ws + WS_PROJ); GAS bf16_t* act = (GAS bf16_t*)(ws + WS_PROJ); GAS bf16_t* mix = (GAS bf16_t*)(ws + WS_MIX);
        GAS float* kvT = (GAS float*)(ws + WS_KVT); GAS bf16_t* st = (GAS bf16_t*)(ws + WS_ST);
        const GAS unsigned* csT = (const GAS unsigned*)(ws + WS_COS);
        const GAS float* mod = (const GAS float*)(ws + WS_MOD); GAS unsigned* ssq = (GAS unsigned*)(ws + WS_SSQ);
        const int l = ph < NPRO ? 0 : (ph - NPRO) / 7, sub = ph < NPRO ? ph - NPRO : (ph - NPRO) % 7;
        const GAS float* modl = mod + l * 6144;
        if (ph == 0) { phase_p0(P, lds, tid, wid, lane, G, bid); }
        else if (ph == 1) { phase_p1(P, tid, G, bid); }
        else if (ph == 2) { phase_p2(P, lds, wid, lane, G, bid); }
        else if (ph == 3) { shw_reduce(ws, 0, bid * 512 + tid, G * 512); }
        else if (sub == 0) {
            pg8::Gemm g{(const bf16_t*)xres, (const bf16_t*)((unsigned char*)ws + WS_WIN) + (size_t)l * INP * DM, SEQ, INP, DM}; pg8::StaticOrder S; S.init(SEQ, INP, G, bid);
            EpiProj E{proj, ssq + (size_t)(2 * l) * SEQ, (const GAS float*)(ws + WS_SHWIN) + l * INP, csT, P.q_norm + l * 64, P.k_norm + l * 64};
            pg8::gemm_phase<EpiProj, pg8::StaticOrder, true, true, true, true>(lds, g, S, E, tid);
        } else if (sub == 1) {
            const bool aff = (G == 256); const int ax = bid & 7, aj = bid >> 3;
            if (aff) chunkkv_items3(lds, proj, kvT, 96 * ax + aj, 32, tid, wid, lane);
            else for (int it = bid; it < 768; it += 3 * G) chunkkv_items3(lds, proj, kvT, it, G, tid, wid, lane);
            for (int it = bid; it < 256; it += G) { const int q = aff ? 32 * ax + aj : it; swa_item(lds, proj, mix, P.sinks + l * 6, q >> 1, q & 1, tid, wid, lane); }
            conv_phase(proj, P.conv_w + l * 768, P.conv_b + l * 256, mix, tid, G, bid);
        } else if (sub == 2) { scan_phase(kvT, st, tid, G, bid);
        } else if (sub == 3) {
            const bool aff = (G == 256); const int ax = bid & 7, aj = bid >> 3;
            if (aff) retout_items(lds, proj, st, P.ret_gn + l * 384, mix, 96 * ax + aj, 32, 3, tid, wid, lane);
            else for (int it = bid; it < 768; it += G) retout_items(lds, proj, st, P.ret_gn + l * 384, mix, it, 0, 1, tid, wid, lane);
        } else if (sub == 4) {
            pg8::Gemm g{(const bf16_t*)mix, (const bf16_t*)((unsigned char*)ws + WS_WOUT) + (size_t)l * DM * DM, SEQ, DM, DM}; pg8::StaticOrder S; S.init(SEQ, DM, G, bid);
            EpiResid<true> E{xres, nullptr, modl + 2048, ssq + (size_t)(2 * l + 1) * SEQ};
#ifdef PROBE_SUB
            if (rep) { E.xres = (GAS bf16_t*)(ws + 320 * MiB); E.ssq_out = (GAS unsigned*)(ws + 352 * MiB); }
#endif
            pg8::gemm_phase<EpiResid<true>, pg8::StaticOrder, true, true, true, true>(lds, g, S, E, tid);
        } else if (sub == 5) {
            pg8::Gemm g{(const bf16_t*)xres, (const bf16_t*)((unsigned char*)ws + WS_WGU) + (size_t)l * GU * DM, SEQ, GU, DM}; pg8::StaticOrder S; S.init(SEQ, GU, G, bid);
            EpiGU E{act, ssq + (size_t)(2 * l + 1) * SEQ, (const GAS float*)(ws + WS_SHWGU) + l * GU};
            pg8::gemm_phase<EpiGU, pg8::StaticOrder, true, true, true, true>(lds, g, S, E, tid);
            if (l + 1 < NL && 2 * bid >= G && rep == 0) { LAS float* scr = (LAS float*)(lds + wid * 16384); const int nb = G - G / 2;
                for (int it = (bid - G / 2) * 8 + wid; it < I_L; it += nb * 8) convert_item(P, l + 1, it, scr, lane); }
        } else {
            pg8::Gemm g{(const bf16_t*)act, (const bf16_t*)((unsigned char*)ws + WS_WDN) + (size_t)l * DM * FH, SEQ, DM, FH}; pg8::StaticOrder S; S.init(SEQ, DM, G, bid);
            if (l == NL - 1) { EpiResid<false> E{xres, P.out, modl + 5120, nullptr};
                pg8::gemm_phase<EpiResid<false>, pg8::StaticOrder, true, true, true, true>(lds, g, S, E, tid); }
            else { EpiResid<true> E{xres, nullptr, modl + 5120, ssq + (size_t)(2 * l + 2) * SEQ};
#ifdef PROBE_SUB
                if (rep) { E.xres = (GAS bf16_t*)(ws + 320 * MiB); E.ssq_out = (GAS unsigned*)(ws + 352 * MiB); }
#endif
                pg8::gemm_phase<EpiResid<true>, pg8::StaticOrder, true, true, true, true>(lds, g, S, E, tid); }
            if (l + 1 < NL) shw_reduce(ws, l + 1, bid * 512 + tid, G * 512);
        }
#ifdef PROBE_SUB
        if (sub == PROBE_SUB && rep == 0 && !(PROBE_SUB == 6 && l == NL - 1)) { rep = 1; --ph; } else rep = 0;
#endif
#ifdef PROBE_SYNC
        for (int i = 0; i < PROBE_SYNC; ++i) { XcdBarrier xb; xb.bar = (unsigned*)((unsigned char*)ws + WS_CTL); xb.x = xb_xcc_id(); xb.st = (volatile LAS unsigned*)(lds + MISC_OFF); xcd_barrier(xb, tid); }
#endif
    }
}

extern "C" void kernel_launch(void* const* d_in, const int* in_sizes, int n_in, void* d_out, int out_size, void* d_ws, size_t ws_size, hipStream_t stream) {
    static int grid = 0;
    if (grid == 0) {
        if (n_in != 16 || out_size != SEQ * DM || ws_size < WS_END) { fprintf(stderr, "kernel_launch: unexpected shapes (n_in %d out %d ws %zu)\n", n_in, out_size, ws_size); grid = -1; return; }
        int dev = 0, cus = 0, per_cu = 0;
        hipGetDevice(&dev); hipDeviceGetAttribute(&cus, hipDeviceAttributeMultiprocessorCount, dev);
        hipFuncSetAttribute((const void*)fwd, hipFuncAttributeMaxDynamicSharedMemorySize, LDS_BYTES);
        hipOccupancyMaxActiveBlocksPerMultiprocessor(&per_cu, (const void*)fwd, 512, LDS_BYTES);
        if (per_cu < 1) { fprintf(stderr, "kernel_launch: occupancy query says %d blocks per CU\n", per_cu); per_cu = 1; }
        (void)hipGetLastError();
        grid = cus * 1;
    }
    if (grid < 0) return;
    if (hipMemsetAsync((char*)d_ws + WS_CTL, 0, CTL_BYTES, stream) != hipSuccess) { fprintf(stderr, "kernel_launch: memset of barrier words failed\n"); return; }
    Args a{};
    for (int i = 0; i < 16; ++i) a.in[i] = (const float*)d_in[i];
    a.out = (float*)d_out; a.ws = (unsigned char*)d_ws;
#if MK_MULTI
    for (int ph = 0; ph < NPH; ++ph) { a.ph_lo = ph; a.ph_hi = ph + 1; hipLaunchKernelGGL(fwd, dim3(grid), dim3(512), LDS_BYTES, stream, a); }
#else
    a.ph_lo = 0; a.ph_hi = NPH;
    void* args[] = {&a};
    hipError_t e = hipLaunchCooperativeKernel((const void*)fwd, dim3(grid), dim3(512), args, LDS_BYTES, stream);
    if (e != hipSuccess) fprintf(stderr, "cooperative launch failed: %s (grid %d)\n", hipGetErrorString(e), grid);
#endif
}
```

```cpp
#include <hip/hip_runtime.h>
#include <hip/hip_cooperative_groups.h>
#include <cstdio>
#include <cstdint>
namespace cg = cooperative_groups;
namespace pg8 {
#define PG8_LAS __attribute__((address_space(3)))
typedef unsigned short bf16_t;
typedef short bf16x8 __attribute__((ext_vector_type(8)));
typedef float f32x4 __attribute__((ext_vector_type(4)));
typedef unsigned u32x4 __attribute__((ext_vector_type(4)));
constexpr int BM = 256, BK = 64, HALF = 128, HTB = HALF * BK * 2  , STAGE_BYTES = 8 * HTB, NXCD = 8, WGM = 8;

__host__ __device__ __forceinline__ int lds_byte(int r, int c) { const int st = (r >> 4) * 2 + (c >> 5), rr = r & 15, cc = c & 31, ob = rr * 64 + cc * 2; return st * 1024 + (ob ^ (((ob >> 9) & 1) << 5)); }
__host__ __device__ __forceinline__ void stage_rc(int b, int& R, int& C) { const int st = b / 1024, sb = b % 1024, swz = sb ^ (((sb >> 9) & 1) << 5); R = (st >> 1) * 16 + swz / 64; C = (st & 1) * 32 + (swz % 64) / 2; }
__host__ __device__ __forceinline__ int perm32(int rho) { const int n = rho >> 4, i = rho & 15; return 8 * (i >> 2) + 4 * n + (i & 3); }

struct Unit { int pm, pn; };
struct Gemm { const bf16_t* A; const bf16_t* Bt; int M, N, K; };

struct StaticOrder {
    int nM, nN, nwg, G, c;
    __host__ __device__ void init(int M, int N, int G_, int c_) { nM = M / BM; nN = N / BM; nwg = nM * nN; G = G_; c = c_; }
    __host__ __device__ bool next(int i, Unit& u) const {
        const long L = (long)i * G + c; if (L >= nwg) return false;
        int wgid = (int)L; { const int q = nwg / NXCD, r = nwg % NXCD, xcd = wgid % NXCD, off = wgid / NXCD; wgid = (xcd < r ? xcd * (q + 1) : r * (q + 1) + (xcd - r) * q) + off; }
        const int nig = WGM * nN, gid = wgid / nig, fm = gid * WGM, gsz = (nM - fm) < WGM ? (nM - fm) : WGM;
        u.pm = fm + ((wgid % nig) % gsz); u.pn = (wgid % nig) / gsz; return true;
    }
    __device__ __forceinline__ void a_ready(const Unit&) const {}
    __device__ __forceinline__ void done(const Unit&) const {}
};
__device__ __forceinline__ unsigned cvt_pk_bf16(float lo, float hi) { unsigned r; asm volatile("v_cvt_pk_bf16_f32 %0, %1, %2" : "=v"(r) : "v"(lo), "v"(hi)); return r; }
template <class Epi, class Sched, bool ALIGN_EPI = false, bool SP2 = false, bool ATILED = false, bool BTILED = false>
__device__ __forceinline__ void gemm_phase(PG8_LAS unsigned char* lds, const Gemm g, const Sched& S, const Epi& E, const int tid) {
    const int wid = __builtin_amdgcn_readfirstlane(tid >> 6), lane = tid & 63, wr = wid >> 2, wc = wid & 3, fr = lane & 15, fq = lane >> 4;
    const int K = g.K, nt = K / BK;
    unsigned voffA[2], voffB[2];
#pragma unroll
    for (int i = 0; i < 2; ++i) { int R, C; stage_rc(tid * 16 + i * 8192, R, C); const int Rb = Epi::PERM ? ((R & ~31) + perm32(R & 31)) : R;
        voffA[i] = (unsigned)(R * (ATILED ? BK : K) + C) * 2u; voffB[i] = (unsigned)(Rb * (BTILED ? BK : K) + C) * 2u; }
    const size_t kstep = (size_t)(BK * 2);
    const size_t hstep = (size_t)HALF * K * 2;
    const size_t tstep = 2 * hstep;
    const size_t kstepA = ATILED ? (size_t)BM * BK * 2 : kstep, hstepA = ATILED ? (size_t)HALF * BK * 2 : hstep, tstepA = ATILED ? (size_t)(K / BK) * BM * BK * 2 : tstep;
    const size_t kstepB = BTILED ? (size_t)BM * BK * 2 : kstep, hstepB = BTILED ? (size_t)HALF * BK * 2 : hstep, tstepB = BTILED ? (size_t)(K / BK) * BM * BK * 2 : tstep;
    const unsigned ldsw = (unsigned)wid * 1024u;
    const int aoff = lds_byte(wr * 64 + fr, fq * 8), boff = lds_byte(wc * 32 + fr, fq * 8);
#define PG8_SA(b, h) (((b) * 2 + (h)) * HTB)
#define PG8_SB(b, h) ((4 + (b) * 2 + (h)) * HTB)
#define PG8_STAGE(bufoff, gbase, voff) do { _Pragma("unroll") for (int _i = 0; _i < 2; ++_i) \
        __builtin_amdgcn_global_load_lds((const unsigned*)((const char*)(gbase) + (voff)[_i]), (PG8_LAS unsigned*)(lds + (bufoff) + ldsw + _i * 8192), 16, 0, 0); } while (0)
#define PG8_LDA(dst, b, h) do { _Pragma("unroll") for (int m = 0; m < 4; ++m) _Pragma("unroll") for (int k = 0; k < 2; ++k) dst[m][k] = *(const PG8_LAS bf16x8*)(lds + PG8_SA(b, h) + aoff + m * 2048 + k * 1024); } while (0)
#define PG8_LDB(dst, b, h) do { _Pragma("unroll") for (int n = 0; n < 2; ++n) _Pragma("unroll") for (int k = 0; k < 2; ++k) dst[n][k] = *(const PG8_LAS bf16x8*)(lds + PG8_SB(b, h) + boff + n * 2048 + k * 1024); } while (0)
#define PG8_MMA(ai, bj, At, Bt) do { __builtin_amdgcn_s_setprio(1); _Pragma("unroll") for (int m = 0; m < 4; ++m) _Pragma("unroll") for (int n = 0; n < 2; ++n) _Pragma("unroll") for (int k = 0; k < 2; ++k) \
        acc[ai][bj][m][n] = __builtin_amdgcn_mfma_f32_16x16x32_bf16(Bt[n][k], At[m][k], acc[ai][bj][m][n], 0, 0, 0); __builtin_amdgcn_s_setprio(0); } while (0)
#define PG8_WAIT_V(n) asm volatile("s_waitcnt vmcnt(" #n ")" ::: "memory")
#define PG8_WAIT_L(n) asm volatile("s_waitcnt lgkmcnt(" #n ")" ::: "memory")
#define PG8_BAR __builtin_amdgcn_s_barrier()
#define PG8_SCHED __builtin_amdgcn_sched_barrier(0)
    Unit cur, nxt; int ui = 0;
    if (!S.next(0, cur)) return;
    f32x4 acc[2][2][4][2];
#pragma unroll
    for (int a = 0; a < 2; ++a)
#pragma unroll
        for (int b = 0; b < 2; ++b)
#pragma unroll
            for (int m = 0; m < 4; ++m)
#pragma unroll
                for (int n = 0; n < 2; ++n) acc[a][b][m][n] = (f32x4){0.f, 0.f, 0.f, 0.f};
    bf16x8 At[4][2], B0[2][2], B1[2][2];
    const char* cA = (const char*)g.A + (size_t)cur.pm * tstepA; const char* cB = (const char*)g.Bt + (size_t)cur.pn * tstepB;
    S.a_ready(cur);
    if constexpr (SP2) {
        PG8_STAGE(PG8_SB(0, 0), cB, voffB); PG8_STAGE(PG8_SB(0, 1), cB + hstepB, voffB); PG8_STAGE(PG8_SA(0, 0), cA, voffA); PG8_STAGE(PG8_SA(0, 1), cA + hstepA, voffA);
        if (wr == 1) PG8_BAR;
        PG8_WAIT_V(2); PG8_BAR;
        PG8_STAGE(PG8_SB(1, 0), cB + kstepB, voffB); PG8_STAGE(PG8_SA(1, 0), cA + kstepA, voffA); PG8_STAGE(PG8_SB(1, 1), cB + hstepB + kstepB, voffB);
        PG8_WAIT_V(6); PG8_BAR;
    } else {
        PG8_STAGE(PG8_SB(0, 0), cB, voffB); PG8_STAGE(PG8_SA(0, 0), cA, voffA); PG8_STAGE(PG8_SB(0, 1), cB + hstepB, voffB); PG8_STAGE(PG8_SA(0, 1), cA + hstepA, voffA);
        if (wr == 1) PG8_BAR;
        PG8_WAIT_V(4); PG8_BAR;
        PG8_STAGE(PG8_SB(1, 0), cB + kstepB, voffB); PG8_STAGE(PG8_SA(1, 0), cA + kstepA, voffA); PG8_STAGE(PG8_SB(1, 1), cB + hstepB + kstepB, voffB);
        PG8_WAIT_V(6); PG8_BAR;
    }
    for (;;) {
        const bool has_next = S.next(ui + 1, nxt);
        const char* nA = has_next ? (const char*)g.A + (size_t)nxt.pm * tstepA : cA; const char* nB = has_next ? (const char*)g.Bt + (size_t)nxt.pn * tstepB : cB;
        for (int t = 0; t < nt; t += 2) {
            const bool last = (t == nt - 2);
            const char* a1 = cA + (size_t)(t + 1) * kstepA;
            const char* a2 = last ? nA : cA + (size_t)(t + 2) * kstepA; const char* b2 = last ? nB : cB + (size_t)(t + 2) * kstepB;
            const char* a3 = a2 + kstepA; const char* b3 = b2 + kstepB;
            if (last && has_next) S.a_ready(nxt);
            if constexpr (SP2) {
            PG8_LDB(B0, 0, 0); PG8_LDB(B1, 0, 1); PG8_SCHED; PG8_LDA(At, 0, 0); PG8_STAGE(PG8_SA(1, 1), a1 + hstepA, voffA);
            PG8_WAIT_V(8); PG8_WAIT_L(0); PG8_BAR; PG8_MMA(0, 0, At, B0); PG8_MMA(0, 1, At, B1); PG8_BAR; PG8_SCHED;
            PG8_LDA(At, 0, 1); PG8_STAGE(PG8_SB(0, 0), b2, voffB); PG8_STAGE(PG8_SB(0, 1), b2 + hstepB, voffB); PG8_STAGE(PG8_SA(0, 0), a2, voffA);
            PG8_WAIT_V(8); PG8_WAIT_L(0); PG8_BAR; PG8_MMA(1, 0, At, B0); PG8_MMA(1, 1, At, B1); PG8_BAR; PG8_SCHED;
            PG8_LDB(B0, 1, 0); PG8_LDB(B1, 1, 1); PG8_SCHED; PG8_LDA(At, 1, 0); PG8_STAGE(PG8_SA(0, 1), a2 + hstepA, voffA);
            PG8_WAIT_V(8); PG8_WAIT_L(0); PG8_BAR; PG8_MMA(0, 0, At, B0); PG8_MMA(0, 1, At, B1); PG8_BAR; PG8_SCHED;
            PG8_LDA(At, 1, 1); PG8_STAGE(PG8_SB(1, 0), b3, voffB); PG8_STAGE(PG8_SB(1, 1), b3 + hstepB, voffB); PG8_STAGE(PG8_SA(1, 0), a3, voffA);
            PG8_WAIT_V(8); PG8_WAIT_L(0); PG8_BAR; PG8_MMA(1, 0, At, B0); PG8_MMA(1, 1, At, B1); PG8_BAR; PG8_SCHED;
            } else {
            PG8_LDB(B0, 0, 0); PG8_SCHED; PG8_LDA(At, 0, 0); PG8_STAGE(PG8_SA(1, 1), a1 + hstepA, voffA);
            PG8_WAIT_L(8); PG8_BAR; PG8_WAIT_L(0); PG8_MMA(0, 0, At, B0); PG8_BAR; PG8_SCHED;
            PG8_LDB(B1, 0, 1); PG8_STAGE(PG8_SB(0, 0), b2, voffB);
            PG8_BAR; PG8_WAIT_L(0); PG8_MMA(0, 1, At, B1); PG8_BAR;
            PG8_LDA(At, 0, 1); PG8_STAGE(PG8_SA(0, 0), a2, voffA);
            PG8_BAR; PG8_WAIT_L(0); PG8_MMA(1, 0, At, B0); PG8_BAR; PG8_SCHED;
            PG8_STAGE(PG8_SB(0, 1), b2 + hstepB, voffB);
            PG8_WAIT_V(6); PG8_BAR; PG8_MMA(1, 1, At, B1); PG8_BAR;
            PG8_LDB(B0, 1, 0); PG8_SCHED; PG8_LDA(At, 1, 0); PG8_STAGE(PG8_SA(0, 1), a2 + hstepA, voffA);
            PG8_WAIT_L(8); PG8_BAR; PG8_WAIT_L(0); PG8_MMA(0, 0, At, B0); PG8_BAR; PG8_SCHED;
            PG8_LDB(B1, 1, 1); PG8_STAGE(PG8_SB(1, 0), b3, voffB);
            PG8_BAR; PG8_WAIT_L(0); PG8_MMA(0, 1, At, B1); PG8_BAR;
            PG8_LDA(At, 1, 1); PG8_STAGE(PG8_SA(1, 0), a3, voffA);
            PG8_BAR; PG8_WAIT_L(0); PG8_MMA(1, 0, At, B0); PG8_BAR; PG8_SCHED;
            PG8_STAGE(PG8_SB(1, 1), b3 + hstepB, voffB);
            PG8_WAIT_V(6); PG8_BAR; PG8_MMA(1, 1, At, B1); PG8_BAR;
            }
        }
        if constexpr (ALIGN_EPI) { if (wr == 0) PG8_BAR; }
        if constexpr (!Epi::AFTER_DRAIN) { E(acc, cur, wr, wc, fr, fq); S.done(cur); }
        if (!has_next) break;
#pragma unroll
        for (int a = 0; a < 2; ++a)
#pragma unroll
            for (int b = 0; b < 2; ++b)
#pragma unroll
                for (int m = 0; m < 4; ++m)
#pragma unroll
                    for (int n = 0; n < 2; ++n) acc[a][b][m][n] = (f32x4){0.f, 0.f, 0.f, 0.f};
        cur = nxt; cA = nA; cB = nB; ++ui;
        if constexpr (ALIGN_EPI) { if (wr == 1) PG8_BAR; }
    }
    PG8_WAIT_V(0);
    if constexpr (!ALIGN_EPI) { if (wr == 0) PG8_BAR; }
    PG8_BAR;
    if constexpr (Epi::AFTER_DRAIN) { E.fused(acc, cur, wr, wc, fr, fq, lds, wid, lane); S.done(cur); }
#undef PG8_SA
#undef PG8_SB
#undef PG8_STAGE
#undef PG8_LDA
#undef PG8_LDB
#undef PG8_MMA
#undef PG8_WAIT_V
#undef PG8_WAIT_L
#undef PG8_BAR
#undef PG8_SCHED
}
}
#define LAS __attribute__((address_space(3)))
#define GAS __attribute__((address_space(1)))
#define XB_TMO      128
#define XB_XCNT(j)  (256  + 64 * (j))
#define XB_XSUB(j)  (1280 + 64 * (j))
#define XB_XGEN(j)  (2304 + 64 * (j))
#define XB_TOP      3328
#define XB_TOPGEN   3392
#define XCD_BAR_WORDS 3456
#define XB_SPIN_CAP (1u << 18)

__device__ __forceinline__ unsigned xb_ld(unsigned* p)              { return __hip_atomic_load(p, __ATOMIC_RELAXED, __HIP_MEMORY_SCOPE_AGENT); }
__device__ __forceinline__ unsigned xb_add(unsigned* p, unsigned v) { return __hip_atomic_fetch_add(p, v, __ATOMIC_RELAXED, __HIP_MEMORY_SCOPE_AGENT); }
__device__ __forceinline__ unsigned xb_xcc_id() { return (unsigned)__builtin_amdgcn_s_getreg((3 << 11) | 20) & 0xFu; }
#define XB_SPIN(cond, bar) do { unsigned _sp = 0; while (cond) { __builtin_amdgcn_s_sleep(1); \
    if ((++_sp & 255u) == 0u) { if (xb_ld(&(bar)[XB_TMO])) break; if (_sp > XB_SPIN_CAP) { atomicAdd(&(bar)[XB_TMO], 1u); break; } } } } while (0)

struct XcdBarrier {
    unsigned* bar; unsigned x;
    volatile LAS unsigned* st;
};

__device__ __forceinline__ XcdBarrier xcd_barrier_post(unsigned* bar, volatile LAS unsigned* st) {
    XcdBarrier b; b.bar = bar; b.x = xb_xcc_id(); b.st = st;
    if (threadIdx.x == 0) (void)xb_add(&bar[XB_XCNT(b.x)], 1u);
    return b;
}
__device__ __forceinline__ void xcd_barrier_complete(unsigned* bar, unsigned x, unsigned& nloc, unsigned& nx) {
    const unsigned G = gridDim.x * gridDim.y * gridDim.z;
    unsigned sum, cnt, mine, sp = 0u;
    for (;;) {
        sum = 0u; cnt = 0u; mine = 0u;
#pragma unroll
        for (unsigned j = 0; j < 16; ++j) { const unsigned c = xb_ld(&bar[XB_XCNT(j)]); sum += c; cnt += (c > 0u) ? 1u : 0u; mine = (j == x) ? c : mine; }
        if (sum == G) break;
        __builtin_amdgcn_s_sleep(1);
        if ((++sp & 255u) == 0u) { if (xb_ld(&bar[XB_TMO])) break; if (sp > XB_SPIN_CAP) { atomicAdd(&bar[XB_TMO], 1u); break; } }
    }
    nloc = mine > 0u ? mine : 1u; nx = cnt > 0u ? cnt : 1u;
}

__device__ __forceinline__ void xcd_barrier(const XcdBarrier& b, const int tid) {
    asm volatile("s_waitcnt vmcnt(0)" ::: "memory");
    __syncthreads();
    if (tid == 0) {
        unsigned* bar = b.bar;
        __builtin_amdgcn_s_waitcnt(0);
        unsigned nloc = b.st[0], nx = b.st[1];
        if (nloc == 0u) { xcd_barrier_complete(bar, b.x, nloc, nx); b.st[0] = nloc; b.st[1] = nx; }
        const unsigned old = xb_add(&bar[XB_XSUB(b.x)], 1u);
        const unsigned gen = old / nloc;
        if (old + 1u == (gen + 1u) * nloc) {
            __builtin_amdgcn_fence(__ATOMIC_RELEASE, "agent");
            asm volatile("s_waitcnt vmcnt(0)" ::: "memory");
            const unsigned og = xb_add(&bar[XB_TOP], 1u);
            const unsigned tg = og / nx;
            if (og + 1u == (tg + 1u) * nx) xb_add(&bar[XB_TOPGEN], 1u);
            else XB_SPIN(xb_ld(&bar[XB_TOPGEN]) == tg, bar);
            __builtin_amdgcn_fence(__ATOMIC_ACQUIRE, "agent");
            xb_add(&bar[XB_XGEN(b.x)], 1u);
            asm volatile("s_waitcnt vmcnt(0)" ::: "memory");
        } else {
            XB_SPIN(xb_ld(&bar[XB_XGEN(b.x)]) == gen, bar);
            __builtin_amdgcn_fence(__ATOMIC_ACQUIRE, "agent");
            asm volatile("s_waitcnt vmcnt(0)" ::: "memory");
        }
    }
    __syncthreads();
}


typedef unsigned short bf16_t;
typedef short bf16x8 __attribute__((ext_vector_type(8)));
typedef float f32x4 __attribute__((ext_vector_type(4)));
typedef unsigned u32x4 __attribute__((ext_vector_type(4)));
typedef unsigned u32x2 __attribute__((ext_vector_type(2)));
typedef float f32x2 __attribute__((ext_vector_type(2)));
using pg8::cvt_pk_bf16;

constexpr int SEQ = 16384, DM = 1024, NL = 4, INW = 2944, INP = 3072, FH = 2816, GU = 5632;
constexpr int C_RQ = 0, C_RK = 384, C_RV = 768, C_RG = 1152, C_AQ = 1536, C_AK = 1920, C_AV = 2048, C_CB = 2176, C_CC = 2432, C_CU = 2688;
constexpr int MIX_SWA = 384, MIX_CONV = 768;
constexpr float EPSF = 1e-6f;
constexpr size_t MiB = 1u << 20;
constexpr size_t WS_WIN = 0, WS_WOUT = 24 * MiB, WS_WGU = 32 * MiB, WS_WDN = 76 * MiB, WS_XG = 98 * MiB, WS_PROJ = 130 * MiB  ,
                 WS_MIX = 226 * MiB, WS_KVT = 258 * MiB, WS_ST = 270 * MiB, WS_COS = 276 * MiB, WS_SIN = 278 * MiB, WS_MODP = 130 * MiB  ,
                 WS_MOD = 283 * MiB, WS_SHWIN = 283 * MiB + 256 * 1024, WS_SHWGU = 283 * MiB + 512 * 1024, WS_SSQ = 284 * MiB, WS_SHP = 280 * MiB  , WS_GP = 283 * MiB + 128 * 1024  , WS_CTL = 285 * MiB, WS_XR = 286 * MiB  , WS_END = 318 * MiB;
constexpr size_t CTL_BYTES = 16384;
constexpr int MISC_OFF = 131072 + 512;
constexpr int LDS_BYTES = 147456;
constexpr int NPRO = 4, NPH = NPRO + 7 * NL;

__device__ __forceinline__ size_t TX(int row, int col) { return ((((size_t)(row >> 8) * 16 + (col >> 6)) * 256 + (row & 255)) << 6) + (col & 63); }
__device__ __forceinline__ size_t PJ(int row, int col) { return ((size_t)(col >> 6) * SEQ + row) * 64 + (col & 63); }
__device__ __forceinline__ float bf2f(unsigned b) { return __uint_as_float(b << 16); }
__device__ __forceinline__ float wave_sum(float v) {
#pragma unroll
    for (int o = 1; o < 64; o <<= 1) v += __shfl_xor(v, o);
    return v;
}
__device__ __forceinline__ float silu_f(float v) { return v * __builtin_amdgcn_rcpf(1.f + __expf(-v)); }
__device__ __forceinline__ float lg2_gamma(int h) { return log2f(1.0f - __builtin_amdgcn_exp2f(-5.0f - (float)h)); }
#define LDS_WAIT() asm volatile("s_waitcnt lgkmcnt(0)" ::: "memory")


struct EpiProj {
    static constexpr bool PERM = true, AFTER_DRAIN = false;
    GAS bf16_t* proj; const GAS unsigned* ssq; const GAS float* shW; const GAS unsigned* csT; const GAS float* qn; const GAS float* kn;
    __device__ __forceinline__ void operator()(const f32x4 (&acc)[2][2][4][2], const pg8::Unit& u, int wr, int wc, int fr, int fq) const {
        const int slot = 4 * u.pn + wc;
        if (slot >= 46) return;
        int type = 2;
        if (slot < 6) type = 0; else if (slot < 12) type = 1; else if (slot < 24) type = 2; else if (slot < 30) type = 3; else if (slot < 32) type = 4;
        const bool do_rope = type != 2, do_norm = type >= 3;
        const float oscale = (type == 1 || type == 3) ? 0.125f : 1.0f;
        const GAS float* gain = (type == 3) ? qn : kn;
        f32x4 sh[2][2], gn[2][2];
#pragma unroll
        for (int bj = 0; bj < 2; ++bj)
#pragma unroll
            for (int n = 0; n < 2; ++n) {
                sh[bj][n] = *(const GAS f32x4*)(shW + 256 * u.pn + 128 * bj + 32 * wc + 8 * fq + 4 * n);
                gn[bj][n] = do_norm ? *(const GAS f32x4*)(gain + 32 * bj + 8 * fq + 4 * n) : (f32x4){1.f, 1.f, 1.f, 1.f};
                if (do_norm) gn[bj][n] = gn[bj][n] * oscale; else sh[bj][n] = sh[bj][n] * oscale;
            }
        const int row0 = 256 * u.pm + 64 * wr + fr;
        float rs[2][4];
#pragma unroll
        for (int ai = 0; ai < 2; ++ai)
#pragma unroll
            for (int m = 0; m < 4; ++m) rs[ai][m] = (float)ssq[row0 + 128 * ai + 16 * m] * (1.0f / 1024.0f);
#pragma unroll
        for (int ai = 0; ai < 2; ++ai) {
            u32x4 cs[4][2];
            if (do_rope) {
#pragma unroll
                for (int m = 0; m < 4; ++m)
#pragma unroll
                    for (int n = 0; n < 2; ++n) cs[m][n] = *(const GAS u32x4*)(csT + (size_t)(row0 + 128 * ai + 16 * m) * 32 + 8 * fq + 4 * n);
            }
#pragma unroll
            for (int m = 0; m < 4; ++m) {
                {
                    const int row = row0 + 128 * ai + 16 * m;
                    const float rstd = __builtin_amdgcn_rsqf(rs[ai][m] * (1.0f / DM) + EPSF) * (do_norm ? 1.0f : oscale);
                    f32x4 v[2][2];
#pragma unroll
                    for (int bj = 0; bj < 2; ++bj)
#pragma unroll
                        for (int n = 0; n < 2; ++n) v[bj][n] = acc[ai][bj][m][n] * rstd + sh[bj][n];
                    if (do_norm) {
                        float s = 0.f;
#pragma unroll
                        for (int bj = 0; bj < 2; ++bj)
#pragma unroll
                            for (int n = 0; n < 2; ++n) { const f32x4 x = v[bj][n]; s += (x[0] * x[0] + x[1] * x[1]) + (x[2] * x[2] + x[3] * x[3]); }
                        s += __shfl_xor(s, 16); s += __shfl_xor(s, 32);
                        const float r = __builtin_amdgcn_rsqf(s * (1.0f / 64.0f) + EPSF);
#pragma unroll
                        for (int bj = 0; bj < 2; ++bj)
#pragma unroll
                            for (int n = 0; n < 2; ++n) v[bj][n] = v[bj][n] * r * gn[bj][n];
                    }
                    if (do_rope) {
#pragma unroll
                        for (int n = 0; n < 2; ++n) { const f32x4 lo = v[0][n], hi = v[1][n]; const u32x4 p = cs[m][n];
                            const f32x4 c4 = {__uint_as_float(p.x << 16), __uint_as_float(p.y << 16), __uint_as_float(p.z << 16), __uint_as_float(p.w << 16)};
                            const f32x4 s4 = {__uint_as_float(p.x & 0xffff0000u), __uint_as_float(p.y & 0xffff0000u), __uint_as_float(p.z & 0xffff0000u), __uint_as_float(p.w & 0xffff0000u)};
                            v[0][n] = lo * c4 - hi * s4; v[1][n] = hi * c4 + lo * s4; }
                    }
#pragma unroll
                    for (int bj = 0; bj < 2; ++bj) {
                        const f32x4 o0 = v[bj][0], o1 = v[bj][1];
                        u32x4 w; w.x = cvt_pk_bf16(o0[0], o0[1]); w.y = cvt_pk_bf16(o0[2], o0[3]); w.z = cvt_pk_bf16(o1[0], o1[1]); w.w = cvt_pk_bf16(o1[2], o1[3]);
                        *(GAS u32x4*)(proj + PJ(row, 64 * slot + 32 * bj + 8 * fq)) = w;
                    }
                }
            }
        }
    }
};
template <bool NXT> struct EpiResid {
    static constexpr bool PERM = true, AFTER_DRAIN = false;
    GAS bf16_t* xres; GAS float* fout; const GAS float* ga; GAS unsigned* ssq_out;
    __device__ __forceinline__ void operator()(const f32x4 (&acc)[2][2][4][2], const pg8::Unit& u, int wr, int wc, int fr, int fq) const {
        const int colb = 256 * u.pn + 32 * wc + 8 * fq, row0 = 256 * u.pm + 64 * wr + fr;
#pragma unroll
        for (int ai = 0; ai < 2; ++ai) {
            float ss[4] = {0.f, 0.f, 0.f, 0.f};
#pragma unroll
            for (int bj = 0; bj < 2; ++bj) {
                const int col = colb + 128 * bj;
                u32x4 xr[4]; f32x4 ga4[2];
#pragma unroll
                for (int m = 0; m < 4; ++m) xr[m] = *(const GAS u32x4*)(xres + TX(row0 + 128 * ai + 16 * m, col));
#pragma unroll
                for (int n = 0; n < 2; ++n) ga4[n] = *(const GAS f32x4*)(ga + col + 4 * n);
#pragma unroll
                for (int m = 0; m < 4; ++m) {
                    const size_t off = (size_t)(row0 + 128 * ai + 16 * m) * DM + col;
                    const f32x4 x0 = {bf2f(xr[m].x & 0xffffu), bf2f(xr[m].x >> 16), bf2f(xr[m].y & 0xffffu), bf2f(xr[m].y >> 16)};
                    const f32x4 x1 = {bf2f(xr[m].z & 0xffffu), bf2f(xr[m].z >> 16), bf2f(xr[m].w & 0xffffu), bf2f(xr[m].w >> 16)};
                    const f32x4 n0 = x0 + ga4[0] * acc[ai][bj][m][0], n1 = x1 + ga4[1] * acc[ai][bj][m][1];
                    if (NXT) {
                        u32x4 w; w.x = cvt_pk_bf16(n0[0], n0[1]); w.y = cvt_pk_bf16(n0[2], n0[3]); w.z = cvt_pk_bf16(n1[0], n1[1]); w.w = cvt_pk_bf16(n1[2], n1[3]);
                        *(GAS u32x4*)(xres + TX(row0 + 128 * ai + 16 * m, col)) = w;
                        { const f32x4 q = n0 * n0 + n1 * n1; ss[m] += (q[0] + q[1]) + (q[2] + q[3]); }
                    } else { *(GAS f32x4*)(fout + off) = n0; *(GAS f32x4*)(fout + off + 4) = n1; }
                }
            }
            if (NXT) {
#pragma unroll
                for (int m = 0; m < 4; ++m) { float s = ss[m]; s += __shfl_xor(s, 16); s += __shfl_xor(s, 32);
                    if (fq == 0) __hip_atomic_fetch_add(ssq_out + row0 + 128 * ai + 16 * m, (unsigned)(s * 1024.0f + 0.5f), __ATOMIC_RELAXED, __HIP_MEMORY_SCOPE_AGENT); }
            }
        }
    }
};
struct EpiGU {
    static constexpr bool PERM = true, AFTER_DRAIN = false;
    GAS bf16_t* act; const GAS unsigned* ssq; const GAS float* shW;
    __device__ __forceinline__ void operator()(const f32x4 (&acc)[2][2][4][2], const pg8::Unit& u, int wr, int wc, int fr, int fq) const {
        f32x4 sh[2][2];
#pragma unroll
        for (int bj = 0; bj < 2; ++bj)
#pragma unroll
            for (int n = 0; n < 2; ++n) sh[bj][n] = *(const GAS f32x4*)(shW + 256 * u.pn + 128 * bj + 32 * wc + 8 * fq + 4 * n);
        const int row0 = 256 * u.pm + 64 * wr + fr;
        float rs[2][4];
#pragma unroll
        for (int ai = 0; ai < 2; ++ai)
#pragma unroll
            for (int m = 0; m < 4; ++m) rs[ai][m] = (float)ssq[row0 + 128 * ai + 16 * m] * (1.0f / 1024.0f);
#pragma unroll
        for (int ai = 0; ai < 2; ++ai)
#pragma unroll
            for (int m = 0; m < 4; ++m) {
                const int row = row0 + 128 * ai + 16 * m;
                const float rstd = __builtin_amdgcn_rsqf(rs[ai][m] * (1.0f / DM) + EPSF);
                f32x4 o[2];
#pragma unroll
                for (int n = 0; n < 2; ++n) {
                    const f32x4 g = acc[ai][0][m][n] * rstd + sh[0][n], uu = acc[ai][1][m][n] * rstd + sh[1][n];
#pragma unroll
                    for (int h = 0; h < 2; ++h) {
                        const f32x2 g2 = {g[2 * h], g[2 * h + 1]}, u2 = {uu[2 * h], uu[2 * h + 1]};
                        const f32x2 t = g2 * (-1.4426950408889634f);
                        f32x2 e; e.x = __builtin_amdgcn_exp2f(t.x); e.y = __builtin_amdgcn_exp2f(t.y);
                        const f32x2 d = e + 1.0f;
                        f32x2 r; r.x = __builtin_amdgcn_rcpf(d.x); r.y = __builtin_amdgcn_rcpf(d.y);
                        const f32x2 p = (g2 * u2) * r;
                        o[n][2 * h] = p.x; o[n][2 * h + 1] = p.y;
                    }
                }
                u32x4 w; w.x = cvt_pk_bf16(o[0][0], o[0][1]); w.y = cvt_pk_bf16(o[0][2], o[0][3]); w.z = cvt_pk_bf16(o[1][0], o[1][1]); w.w = cvt_pk_bf16(o[1][2], o[1][3]);
                *(GAS u32x4*)(act + (((size_t)u.pm * (FH / 64) + 2 * u.pn + (wc >> 1)) * 256 + (row - 256 * u.pm)) * 64 + 32 * (wc & 1) + 8 * fq) = w;
            }
    }
};

__device__ __forceinline__ void transpose_item(const GAS float* W, int K, int N, int srccol0, GAS bf16_t* WT, int dstrow0, int k0, LAS float* scr, int lane,
                                               const GAS float* gp, const GAS float* shv, GAS float* shp) {
    const int nq = lane & 7, kr = lane >> 3;
    f32x4 v[8];
#pragma unroll
    for (int i = 0; i < 8; ++i) v[i] = (srccol0 >= 0) ? *(const GAS f32x4*)(W + (size_t)(k0 + 8 * i + kr) * N + srccol0 + 4 * nq) : (f32x4){0.f, 0.f, 0.f, 0.f};
    if (gp) {
        float gk[8], sk[8];
#pragma unroll
        for (int i = 0; i < 8; ++i) { gk[i] = gp[k0 + 8 * i + kr]; sk[i] = shv[k0 + 8 * i + kr]; }
        f32x4 ps = {0.f, 0.f, 0.f, 0.f};
#pragma unroll
        for (int i = 0; i < 8; ++i) { ps += v[i] * sk[i]; v[i] = v[i] * gk[i]; }
#pragma unroll
        for (int c = 0; c < 4; ++c) { float t = ps[c]; t += __shfl_xor(t, 8); t += __shfl_xor(t, 16); t += __shfl_xor(t, 32); ps[c] = t; }
        if (kr == 0) *(GAS f32x4*)(shp + dstrow0 + 4 * nq) = ps;
    }
#pragma unroll
    for (int i = 0; i < 8; ++i) { LAS float* d = scr + (8 * i + kr) * 33 + 4 * nq; d[0] = v[i][0]; d[1] = v[i][1]; d[2] = v[i][2]; d[3] = v[i][3]; }
    LDS_WAIT();
    const int c = lane & 7;
#pragma unroll
    for (int j = 0; j < 4; ++j) { const int n = (lane >> 3) + 8 * j; const LAS float* s = scr + (8 * c) * 33 + n;
        u32x4 o; o.x = cvt_pk_bf16(s[0 * 33], s[1 * 33]); o.y = cvt_pk_bf16(s[2 * 33], s[3 * 33]); o.z = cvt_pk_bf16(s[4 * 33], s[5 * 33]); o.w = cvt_pk_bf16(s[6 * 33], s[7 * 33]);
        const int row = dstrow0 + n;
        *(GAS u32x4*)(WT + ((((size_t)(row >> 8) * (K >> 6) + (k0 >> 6)) * 256 + (row & 255)) << 6) + 8 * c) = o; }
    LDS_WAIT();
}

struct Ptrs {
    const GAS float *x, *c, *w_ada, *b_ada, *g_mix, *w_in, *conv_w, *conv_b, *q_norm, *k_norm, *sinks, *ret_gn, *w_out, *g_ffn, *w_gu, *w_down;
    GAS float* out; GAS unsigned char* ws;
};

constexpr int SHW_N = INP + GU;
constexpr int I_IN = 16 * 96, I_OUT = 16 * 32, I_GU = 16 * 176, I_DN = 44 * 32, I_L = I_IN + I_OUT + I_GU + I_DN;
__device__ __forceinline__ void convert_item(const Ptrs& P, int l, int r, LAS float* scr, int lane) {
    GAS unsigned char* ws = P.ws;
    const GAS float* mod = (const GAS float*)(ws + WS_MOD) + l * 6144; const GAS float* gp = (const GAS float*)(ws + WS_GP) + l * 2048;
    GAS float* shp = (GAS float*)(ws + WS_SHP) + (size_t)l * 16 * SHW_N;
    if (r < I_IN) { const int kb = r / 96, nb = r % 96, n0 = 32 * nb, pn = n0 >> 8, t = n0 & 255, bj = t >> 7, wc = (t >> 5) & 3, slot = 4 * pn + wc;
        transpose_item(P.w_in + (size_t)l * DM * INW, DM, INW, slot < 46 ? 64 * slot + 32 * bj : -1, (GAS bf16_t*)(ws + WS_WIN) + (size_t)l * INP * DM, n0, 64 * kb, scr, lane,
                       gp, mod, shp + (size_t)kb * SHW_N); return; }
    r -= I_IN;
    if (r < I_OUT) { const int kb = r / 32, nb = r % 32;
        transpose_item(P.w_out + (size_t)l * DM * DM, DM, DM, 32 * nb, (GAS bf16_t*)(ws + WS_WOUT) + (size_t)l * DM * DM, 32 * nb, 64 * kb, scr, lane, nullptr, nullptr, nullptr); return; }
    r -= I_OUT;
    if (r < I_GU) { const int kb = r / 176, nb = r % 176, n0 = 32 * nb, pn = n0 >> 8, t = n0 & 255, bj = t >> 7, j = t & 127;
        transpose_item(P.w_gu + (size_t)l * DM * GU, DM, GU, bj * FH + 128 * pn + j, (GAS bf16_t*)(ws + WS_WGU) + (size_t)l * GU * DM, n0, 64 * kb, scr, lane,
                       gp + 1024, mod + 3072, shp + (size_t)kb * SHW_N + INP); return; }
    r -= I_GU;
    { const int kb = r / 32, nb = r % 32;
        transpose_item(P.w_down + (size_t)l * FH * DM, FH, DM, 32 * nb, (GAS bf16_t*)(ws + WS_WDN) + (size_t)l * DM * FH, 32 * nb, 64 * kb, scr, lane, nullptr, nullptr, nullptr); }
}
__device__ __forceinline__ void shw_reduce(GAS unsigned char* ws, int l, int gt, int NGT) {
    const GAS float* shp = (const GAS float*)(ws + WS_SHP) + (size_t)l * 16 * SHW_N;
    for (int i = gt; i < SHW_N; i += NGT) { float a = 0.f;
#pragma unroll
        for (int kb = 0; kb < 16; ++kb) a += shp[(size_t)kb * SHW_N + i];
        if (i < INP) ((GAS float*)(ws + WS_SHWIN))[l * INP + i] = a; else ((GAS float*)(ws + WS_SHWGU))[l * GU + i - INP] = a; }
}

__device__ __forceinline__ void phase_p0(const Ptrs& P, LAS unsigned char* lds, int tid, int wid, int lane, int G, int bid) {
    GAS unsigned char* ws = P.ws;
    const int gt = bid * 512 + tid, NGT = G * 512;
    GAS float* part = (GAS float*)(ws + WS_MODP);
    for (int it = gt; it < NL * 64 * 1536; it += NGT) {
        const int e4 = it % 1536, ls = it / 1536, s = ls & 63, l = ls >> 6;
        const GAS float* wp = P.w_ada + ((size_t)l * DM + 16 * s) * 6144 + 4 * e4;
        f32x4 wv[16];
#pragma unroll
        for (int k = 0; k < 16; ++k) wv[k] = *(const GAS f32x4*)(wp + (size_t)k * 6144);
        f32x4 a = {0.f, 0.f, 0.f, 0.f};
#pragma unroll
        for (int k = 0; k < 16; ++k) a += wv[k] * silu_f(P.c[16 * s + k]);
        *(GAS f32x4*)(part + (size_t)ls * 6144 + 4 * e4) = a;
    }
    GAS unsigned* csT = (GAS unsigned*)(ws + WS_COS);
    for (int it = gt; it < SEQ * 32; it += NGT) {
        const int pos = it >> 5, j = it & 31;
        const float inv = 1.0f / powf(10000.0f, (float)(2 * j) / 64.0f);
        const float ang = (float)pos * inv;
        csT[it] = cvt_pk_bf16(cosf(ang), sinf(ang));
    }
    GAS unsigned* ssq = (GAS unsigned*)(ws + WS_SSQ);
    for (int it = gt; it < 8 * SEQ; it += NGT) ssq[it] = 0u;
}

__device__ __forceinline__ void phase_p1(const Ptrs& P, int tid, int G, int bid) {
    const GAS float* part = (const GAS float*)(P.ws + WS_MODP); GAS float* mod = (GAS float*)(P.ws + WS_MOD); GAS float* gp = (GAS float*)(P.ws + WS_GP);
    for (int it = bid * 512 + tid; it < NL * 6144; it += G * 512) {
        const int l = it / 6144, e = it % 6144; float a = P.b_ada[it];
        float pv[64];
#pragma unroll
        for (int s = 0; s < 64; ++s) pv[s] = part[((size_t)l * 64 + s) * 6144 + e];
#pragma unroll
        for (int s = 0; s < 64; ++s) a += pv[s];
        mod[it] = a;
        if (e >= 1024 && e < 2048) gp[l * 2048 + e - 1024] = P.g_mix[l * DM + e - 1024] * (1.0f + a);
        if (e >= 4096 && e < 5120) gp[l * 2048 + 1024 + e - 4096] = P.g_ffn[l * DM + e - 4096] * (1.0f + a);
    }
}

__device__ __forceinline__ void phase_p2(const Ptrs& P, LAS unsigned char* lds, int wid, int lane, int G, int bid) {
    GAS unsigned char* ws = P.ws;
    const int gw = bid * 8 + wid, NGW = G * 8;
    LAS float* scr = (LAS float*)(lds + wid * 16384);
    for (int it = gw; it < I_L; it += NGW) convert_item(P, 0, it, scr, lane);
    for (int it = gw; it < SEQ / 2; it += NGW) {
        const int row0 = 2 * it;
        f32x4 xv[2][4];
#pragma unroll
        for (int q = 0; q < 2; ++q)
#pragma unroll
            for (int j = 0; j < 4; ++j) xv[q][j] = *(const GAS f32x4*)(P.x + (size_t)(row0 + q) * DM + 4 * lane + 256 * j);
#pragma unroll
        for (int q = 0; q < 2; ++q) { float s = 0.f; GAS bf16_t* xr = (GAS bf16_t*)(ws + WS_XR);
#pragma unroll
            for (int j = 0; j < 4; ++j) { const f32x4 x4 = xv[q][j]; u32x2 r; r.x = cvt_pk_bf16(x4[0], x4[1]); r.y = cvt_pk_bf16(x4[2], x4[3]); *(GAS u32x2*)(xr + TX(row0 + q, 4 * lane + 256 * j)) = r;
                s += (x4[0] * x4[0] + x4[1] * x4[1]) + (x4[2] * x4[2] + x4[3] * x4[3]); }
            s = wave_sum(s);
            if (lane == 0) ((GAS unsigned*)(ws + WS_SSQ))[row0 + q] = (unsigned)(s * 1024.0f + 0.5f); }
    }
}

__device__ __forceinline__ int tsw(int d) { return ((d >> 3) & 7) << 3; }
#define MFMA16(a, b, c) __builtin_amdgcn_mfma_f32_16x16x32_bf16(a, b, c, 0, 0, 0)
__device__ __forceinline__ bf16x8 mk8(u32x2 a, u32x2 b) { u32x4 t; t.x = a.x; t.y = a.y; t.z = b.x; t.w = b.y; return __builtin_bit_cast(bf16x8, t); }

__device__ __forceinline__ void swa_item(LAS unsigned char* lds, const GAS bf16_t* proj, GAS bf16_t* mix, const GAS float* sinks, int nb, int hk, int tid, int w, int lane) {
    constexpr int KS = 72, VS = 328;
    LAS bf16_t* Ks = (LAS bf16_t*)lds;
    LAS bf16_t* VTs = (LAS bf16_t*)(lds + 36864);
    const int t0 = nb * 128;
    const int fr = lane & 15, fq = lane >> 4, ql = 16 * w + fr, tq = t0 + ql;
    u32x4 kreg[4], vreg[4]; bf16x8 qfa[3][2];
#pragma unroll
    for (int i = 0; i < 4; ++i) { const int c = tid + 512 * i, r = c >> 3, dc = (c & 7) * 8, tok = t0 - 128 + r;
        kreg[i] = (u32x4){0u, 0u, 0u, 0u}; vreg[i] = (u32x4){0u, 0u, 0u, 0u};
        if (tok >= 0) { kreg[i] = *(const GAS u32x4*)(proj + PJ(tok, C_AK + 64 * hk + dc)); vreg[i] = *(const GAS u32x4*)(proj + PJ(tok, C_AV + 64 * hk + dc)); } }
#pragma unroll
    for (int g = 0; g < 3; ++g)
#pragma unroll
        for (int c = 0; c < 2; ++c) qfa[g][c] = *(const GAS bf16x8*)(proj + PJ(tq, C_AQ + 64 * (3 * hk + g)) + 32 * c + 8 * fq);
#pragma unroll
    for (int i = 0; i < 4; ++i) { const int c = tid + 512 * i, r = c >> 3, dc = (c & 7) * 8;
        *(LAS u32x4*)(Ks + r * KS + dc) = kreg[i];
        const u32x4 v = vreg[i]; LAS bf16_t* d = VTs + dc * VS + (r ^ tsw(dc));
        d[0 * VS] = (bf16_t)(v.x & 0xffffu); d[1 * VS] = (bf16_t)(v.x >> 16); d[2 * VS] = (bf16_t)(v.y & 0xffffu); d[3 * VS] = (bf16_t)(v.y >> 16);
        d[4 * VS] = (bf16_t)(v.z & 0xffffu); d[5 * VS] = (bf16_t)(v.z >> 16); d[6 * VS] = (bf16_t)(v.w & 0xffffu); d[7 * VS] = (bf16_t)(v.w >> 16); }
    for (int c = tid; c < 64 * 64; c += 512) { const int e = c >> 6, k = 256 + (c & 63); VTs[e * VS + k] = 0; }
    __syncthreads();
#pragma unroll
    for (int g = 0; g < 3; ++g) {
        const int hq = 3 * hk + g;
        bf16x8 qf[2]; qf[0] = qfa[g][0]; qf[1] = qfa[g][1];
        f32x4 s[9];
#pragma unroll
        for (int j = 0; j < 9; ++j) { s[j] = (f32x4){0.f, 0.f, 0.f, 0.f};
#pragma unroll
            for (int c = 0; c < 2; ++c) { const bf16x8 a = *(const LAS bf16x8*)(Ks + (16 * (w + j) + fr) * KS + 32 * c + 8 * fq); s[j] = MFMA16(a, qf[c], s[j]); } }
        const float sink = sinks[hq];
        float mx = sink;
#pragma unroll
        for (int j = 0; j < 9; ++j)
#pragma unroll
            for (int i = 0; i < 4; ++i) { const int kpos = 16 * (w + j) + 4 * fq + i;
                if (j == 0) s[j][i] = kpos > ql ? s[j][i] : -1e30f;
                if (j == 8) s[j][i] = kpos <= ql + 128 ? s[j][i] : -1e30f; }
        if (nb == 0) {
#pragma unroll
            for (int j = 0; j < 9; ++j)
#pragma unroll
                for (int i = 0; i < 4; ++i) s[j][i] = (16 * (w + j) + 4 * fq + i) >= 128 ? s[j][i] : -1e30f;
        }
#pragma unroll
        for (int j = 0; j < 9; ++j)
#pragma unroll
            for (int i = 0; i < 4; ++i) mx = fmaxf(mx, s[j][i]);
        mx = fmaxf(mx, __shfl_xor(mx, 16)); mx = fmaxf(mx, __shfl_xor(mx, 32));
        float sum = 0.f; const float nmx = -mx * 1.4426950408889634f;
#pragma unroll
        for (int j = 0; j < 9; ++j)
#pragma unroll
            for (int i = 0; i < 4; ++i) { const float p = __builtin_amdgcn_exp2f(__builtin_fmaf(s[j][i], 1.4426950408889634f, nmx)); s[j][i] = p; sum += p; }
        sum += __shfl_xor(sum, 16); sum += __shfl_xor(sum, 32);
        const float inv = __builtin_amdgcn_rcpf(sum + __expf(sink - mx));
        f32x4 o[4];
#pragma unroll
        for (int et = 0; et < 4; ++et) o[et] = (f32x4){0.f, 0.f, 0.f, 0.f};
#pragma unroll
        for (int jj = 0; jj < 5; ++jj) {
            const int j0 = 2 * jj, j1 = 2 * jj + 1;
            u32x2 plo, phi; plo.x = cvt_pk_bf16(s[j0][0], s[j0][1]); plo.y = cvt_pk_bf16(s[j0][2], s[j0][3]);
            if (j1 < 9) { phi.x = cvt_pk_bf16(s[j1 < 9 ? j1 : 0][0], s[j1 < 9 ? j1 : 0][1]); phi.y = cvt_pk_bf16(s[j1 < 9 ? j1 : 0][2], s[j1 < 9 ? j1 : 0][3]); } else { phi.x = 0u; phi.y = 0u; }
            const bf16x8 pb = mk8(plo, phi);
#pragma unroll
            for (int et = 0; et < 4; ++et) {
                const LAS bf16_t* vr = VTs + (16 * et + fr) * VS; const int sw = tsw(16 * et + fr), kc0 = 16 * (w + j0) + 4 * fq;
                const u32x2 a0 = *(const LAS u32x2*)(vr + (kc0 ^ sw)), a1 = *(const LAS u32x2*)(vr + ((kc0 + 16) ^ sw));
                o[et] = MFMA16(mk8(a0, a1), pb, o[et]);
            }
        }
#pragma unroll
        for (int et = 0; et < 4; ++et) { const f32x4 v = o[et] * inv; u32x2 wv; wv.x = cvt_pk_bf16(v[0], v[1]); wv.y = cvt_pk_bf16(v[2], v[3]);
            *(GAS u32x2*)(mix + TX(tq, MIX_SWA + 64 * hq + 16 * et + 4 * fq)) = wv; }
    }
    __syncthreads();
}

__device__ __forceinline__ void chunkkv_items3(LAS unsigned char* lds, const GAS bf16_t* proj, GAS float* kvT, int it0, int stride, int tid, int w, int lane) {
    constexpr int TS = 136, IMG = 2 * 64 * TS * 2;
    u32x4 kreg[3][2], vreg[3][2];
#pragma unroll
    for (int j = 0; j < 3; ++j) { const int it = it0 + j * stride;
        if (it < 768) { const int n = it / 6, h = it % 6;
#pragma unroll
            for (int i = 0; i < 2; ++i) { const int c = tid + 512 * i, r = c >> 3, dc = (c & 7) * 8;
                kreg[j][i] = *(const GAS u32x4*)(proj + PJ((n * 128 + r), C_RK + 64 * h + dc));
                vreg[j][i] = *(const GAS u32x4*)(proj + PJ((n * 128 + r), C_RV + 64 * h + dc)); } } }
#pragma unroll
    for (int j = 0; j < 3; ++j) { const int it = it0 + j * stride;
        if (it < 768) { const float lg2 = lg2_gamma(it % 6);
            LAS bf16_t* KTs = (LAS bf16_t*)(lds + j * IMG); LAS bf16_t* VTs = KTs + 64 * TS;
#pragma unroll
            for (int i = 0; i < 2; ++i) { const int c = tid + 512 * i, r = c >> 3, dc = (c & 7) * 8;
                const u32x4 kv = kreg[j][i], vv = vreg[j][i];
                const float wk = __builtin_amdgcn_exp2f(lg2 * (float)(127 - r));
                LAS bf16_t* dk = KTs + dc * TS + (r ^ tsw(dc)); LAS bf16_t* dv = VTs + dc * TS + (r ^ tsw(dc));
                const unsigned k01 = cvt_pk_bf16(bf2f(kv.x & 0xffffu) * wk, bf2f(kv.x >> 16) * wk), k23 = cvt_pk_bf16(bf2f(kv.y & 0xffffu) * wk, bf2f(kv.y >> 16) * wk),
                               k45 = cvt_pk_bf16(bf2f(kv.z & 0xffffu) * wk, bf2f(kv.z >> 16) * wk), k67 = cvt_pk_bf16(bf2f(kv.w & 0xffffu) * wk, bf2f(kv.w >> 16) * wk);
                dk[0 * TS] = (bf16_t)(k01 & 0xffffu); dk[1 * TS] = (bf16_t)(k01 >> 16); dk[2 * TS] = (bf16_t)(k23 & 0xffffu); dk[3 * TS] = (bf16_t)(k23 >> 16);
                dk[4 * TS] = (bf16_t)(k45 & 0xffffu); dk[5 * TS] = (bf16_t)(k45 >> 16); dk[6 * TS] = (bf16_t)(k67 & 0xffffu); dk[7 * TS] = (bf16_t)(k67 >> 16);
                dv[0 * TS] = (bf16_t)(vv.x & 0xffffu); dv[1 * TS] = (bf16_t)(vv.x >> 16); dv[2 * TS] = (bf16_t)(vv.y & 0xffffu); dv[3 * TS] = (bf16_t)(vv.y >> 16);
                dv[4 * TS] = (bf16_t)(vv.z & 0xffffu); dv[5 * TS] = (bf16_t)(vv.z >> 16); dv[6 * TS] = (bf16_t)(vv.w & 0xffffu); dv[7 * TS] = (bf16_t)(vv.w >> 16); } } }
    __syncthreads();
    const int fr = lane & 15, fq = lane >> 4, et = w >> 1;
#pragma unroll
    for (int j = 0; j < 3; ++j) { const int it = it0 + j * stride;
        if (it < 768) { const int n = it / 6, h = it % 6;
            const LAS bf16_t* KTs = (const LAS bf16_t*)(lds + j * IMG); const LAS bf16_t* VTs = KTs + 64 * TS;
#pragma unroll
            for (int dd = 0; dd < 2; ++dd) { const int dt = 2 * (w & 1) + dd;
                f32x4 acc = {0.f, 0.f, 0.f, 0.f};
#pragma unroll
                for (int kc = 0; kc < 4; ++kc) { const bf16x8 a = *(const LAS bf16x8*)(VTs + (16 * et + fr) * TS + ((32 * kc + 8 * fq) ^ tsw(16 * et + fr))), b = *(const LAS bf16x8*)(KTs + (16 * dt + fr) * TS + ((32 * kc + 8 * fq) ^ tsw(16 * dt + fr)));
                    acc = MFMA16(a, b, acc); }
                GAS float* dst = kvT + ((size_t)(n * 6 + h) * 64 + 16 * et + 4 * fq) * 64 + 16 * dt + fr;
#pragma unroll
                for (int i = 0; i < 4; ++i) dst[i * 64] = acc[i];
            } } }
    __syncthreads();
}

__device__ __forceinline__ void scan_phase(const GAS float* kvT, GAS bf16_t* st, int tid, int G, int bid) {
    for (int idx = bid * 512 + tid; idx < 24576; idx += G * 512) {
        const int h = idx >> 12; const float dec = __builtin_amdgcn_exp2f(lg2_gamma(h) * 128.0f);
        float S = 0.f;
        for (int n0 = 0; n0 < 128; n0 += 64) {
            float kv[64];
#pragma unroll
            for (int i = 0; i < 64; ++i) kv[i] = kvT[(size_t)(n0 + i) * 24576 + idx];
#pragma unroll
            for (int i = 0; i < 64; ++i) { st[(size_t)(n0 + i) * 24576 + idx] = (bf16_t)(cvt_pk_bf16(S, 0.f) & 0xffffu); S = S * dec + kv[i]; }
        }
    }
}

__device__ __forceinline__ void retout_items(LAS unsigned char* lds, const GAS bf16_t* proj, const GAS bf16_t* st, const GAS float* gnw, GAS bf16_t* mix, int q0, int qstride, int nit, int tid, int w, int lane) {
    constexpr int KS = 72, VS = 200, SS = 72;
    LAS bf16_t* Ks = (LAS bf16_t*)lds;
    LAS bf16_t* VTs = (LAS bf16_t*)(lds + 18432);
    LAS bf16_t* STs = (LAS bf16_t*)(lds + 44032);
    const int fr = lane & 15, fq = lane >> 4, ql = 16 * w + fr;
    u32x4 kreg[2], vreg[2], sreg; bf16x8 qreg[2]; u32x2 greg[4];
#define RET_LOADS(qq) do { const int n_ = (qq) / 6, h_ = (qq) % 6, t0_ = n_ * 128; \
        _Pragma("unroll") for (int i = 0; i < 2; ++i) { const int c = tid + 512 * i, r = c >> 3, dc = (c & 7) * 8; \
            kreg[i] = *(const GAS u32x4*)(proj + PJ(t0_ + r, C_RK + 64 * h_ + dc)); vreg[i] = *(const GAS u32x4*)(proj + PJ(t0_ + r, C_RV + 64 * h_ + dc)); } \
        sreg = *(const GAS u32x4*)(st + ((size_t)(n_ * 6 + h_) * 64 + (tid >> 3)) * 64 + (tid & 7) * 8); \
        _Pragma("unroll") for (int c = 0; c < 2; ++c) qreg[c] = *(const GAS bf16x8*)(proj + PJ(t0_ + ql, C_RQ + 64 * h_ + 32 * c + 8 * fq)); \
        _Pragma("unroll") for (int et = 0; et < 4; ++et) greg[et] = *(const GAS u32x2*)(proj + PJ(t0_ + ql, C_RG + 64 * h_ + 16 * et + 4 * fq)); } while (0)
    RET_LOADS(q0);
#pragma unroll 1
    for (int k = 0; k < nit; ++k) {
        const int q = q0 + k * qstride, n = q / 6, h = q % 6, t0 = n * 128, tq = t0 + ql; const float lg2 = lg2_gamma(h);
#pragma unroll
        for (int i = 0; i < 2; ++i) { const int c = tid + 512 * i, r = c >> 3, dc = (c & 7) * 8;
            *(LAS u32x4*)(Ks + r * KS + dc) = kreg[i];
            const u32x4 vv = vreg[i]; LAS bf16_t* dv = VTs + dc * VS + (r ^ tsw(dc));
            dv[0 * VS] = (bf16_t)(vv.x & 0xffffu); dv[1 * VS] = (bf16_t)(vv.x >> 16); dv[2 * VS] = (bf16_t)(vv.y & 0xffffu); dv[3 * VS] = (bf16_t)(vv.y >> 16);
            dv[4 * VS] = (bf16_t)(vv.z & 0xffffu); dv[5 * VS] = (bf16_t)(vv.z >> 16); dv[6 * VS] = (bf16_t)(vv.w & 0xffffu); dv[7 * VS] = (bf16_t)(vv.w >> 16); }
        *(LAS u32x4*)(STs + (tid >> 3) * SS + (tid & 7) * 8) = sreg;
        bf16x8 qf[2]; qf[0] = qreg[0]; qf[1] = qreg[1];
        u32x2 gvv[4];
#pragma unroll
        for (int et = 0; et < 4; ++et) gvv[et] = greg[et];
        __syncthreads();
        if (k + 1 < nit) RET_LOADS(q + qstride);
        f32x4 gnv[4];
#pragma unroll
        for (int et = 0; et < 4; ++et) gnv[et] = *(const GAS f32x4*)(gnw + 64 * h + 16 * et + 4 * fq);
        f32x4 av, avm;
#pragma unroll
        for (int i = 0; i < 4; ++i) { const int d = fr - 4 * fq - i; const float e = __builtin_amdgcn_exp2f(lg2 * (float)d); av[i] = e; avm[i] = d >= 0 ? e : 0.f; }
        f32x4 s[8];
#pragma unroll
        for (int kt = 0; kt < 8; ++kt) { s[kt] = (f32x4){0.f, 0.f, 0.f, 0.f};
            if (kt <= w) {
#pragma unroll
                for (int c = 0; c < 2; ++c) { const bf16x8 a = *(const LAS bf16x8*)(Ks + (16 * kt + fr) * KS + 32 * c + 8 * fq); s[kt] = MFMA16(a, qf[c], s[kt]); }
                if (kt == w) s[kt] = s[kt] * avm; else s[kt] = s[kt] * (av * __builtin_amdgcn_exp2f(lg2 * (float)(16 * (w - kt))));
            } }
        f32x4 o[4], cr[4];
#pragma unroll
        for (int et = 0; et < 4; ++et) { o[et] = (f32x4){0.f, 0.f, 0.f, 0.f}; cr[et] = (f32x4){0.f, 0.f, 0.f, 0.f}; }
#pragma unroll
        for (int jj = 0; jj < 4; ++jj) {
            if (2 * jj <= w) {
                u32x2 plo, phi; plo.x = cvt_pk_bf16(s[2 * jj][0], s[2 * jj][1]); plo.y = cvt_pk_bf16(s[2 * jj][2], s[2 * jj][3]);
                phi.x = cvt_pk_bf16(s[2 * jj + 1][0], s[2 * jj + 1][1]); phi.y = cvt_pk_bf16(s[2 * jj + 1][2], s[2 * jj + 1][3]);
                const bf16x8 pb = mk8(plo, phi);
#pragma unroll
                for (int et = 0; et < 4; ++et) {
                    const LAS bf16_t* vr = VTs + (16 * et + fr) * VS; const int sw = tsw(16 * et + fr), kc0 = 32 * jj + 4 * fq;
                    const u32x2 a0 = *(const LAS u32x2*)(vr + (kc0 ^ sw)), a1 = *(const LAS u32x2*)(vr + ((kc0 + 16) ^ sw));
                    o[et] = MFMA16(mk8(a0, a1), pb, o[et]);
                }
            }
        }
#pragma unroll
        for (int et = 0; et < 4; ++et)
#pragma unroll
            for (int c = 0; c < 2; ++c) { const bf16x8 a = *(const LAS bf16x8*)(STs + (16 * et + fr) * SS + 32 * c + 8 * fq); cr[et] = MFMA16(a, qf[c], cr[et]); }
        const float qd = __builtin_amdgcn_exp2f(lg2 * (float)(ql + 1));
        float s1 = 0.f;
#pragma unroll
        for (int et = 0; et < 4; ++et) { o[et] = o[et] + cr[et] * qd; s1 += (o[et][0] + o[et][1]) + (o[et][2] + o[et][3]); }
        s1 += __shfl_xor(s1, 16); s1 += __shfl_xor(s1, 32);
        const float mean = s1 * (1.0f / 64.0f);
        float s2 = 0.f;
#pragma unroll
        for (int et = 0; et < 4; ++et) { o[et] = o[et] - mean; s2 += (o[et][0] * o[et][0] + o[et][1] * o[et][1]) + (o[et][2] * o[et][2] + o[et][3] * o[et][3]); }
        s2 += __shfl_xor(s2, 16); s2 += __shfl_xor(s2, 32);
        const float rs = __builtin_amdgcn_rsqf(s2 * (1.0f / 64.0f) + EPSF);
#pragma unroll
        for (int et = 0; et < 4; ++et) {
            const int col = 64 * h + 16 * et + 4 * fq;
            const u32x2 gv = gvv[et]; const f32x4 gn = gnv[et];
            f32x4 y;
            y[0] = o[et][0] * rs * gn[0] * silu_f(bf2f(gv.x & 0xffffu)); y[1] = o[et][1] * rs * gn[1] * silu_f(bf2f(gv.x >> 16));
            y[2] = o[et][2] * rs * gn[2] * silu_f(bf2f(gv.y & 0xffffu)); y[3] = o[et][3] * rs * gn[3] * silu_f(bf2f(gv.y >> 16));
            u32x2 wv; wv.x = cvt_pk_bf16(y[0], y[1]); wv.y = cvt_pk_bf16(y[2], y[3]);
            *(GAS u32x2*)(mix + TX(tq, col)) = wv;
        }
        __syncthreads();
    }
#undef RET_LOADS
}

__device__ __forceinline__ void unpk8(const u32x4 v, f32x4& lo, f32x4& hi) {
    lo = (f32x4){__uint_as_float(v.x << 16), __uint_as_float(v.x & 0xffff0000u), __uint_as_float(v.y << 16), __uint_as_float(v.y & 0xffff0000u)};
    hi = (f32x4){__uint_as_float(v.z << 16), __uint_as_float(v.z & 0xffff0000u), __uint_as_float(v.w << 16), __uint_as_float(v.w & 0xffff0000u)};
}
__device__ __forceinline__ void conv_phase(const GAS bf16_t* proj, const GAS float* cw, const GAS float* cb_, GAS bf16_t* mix, int tid, int G, int bid) {
    for (int it0 = bid * 512 + tid; it0 < (SEQ / 4) * 32; it0 += G * 512) {
        const int it = (G == 256) ? (((512 * (bid & 7) + 16 * (bid >> 3)) << 5) + tid) : it0;
        const int t0 = (it >> 5) * 4, c8 = (it & 31) * 8;
        u32x4 ccr[6], cur[6], cbr[4];
#pragma unroll
        for (int r = 0; r < 6; ++r) { const int tt = t0 - 2 + r;
            ccr[r] = (u32x4){0u, 0u, 0u, 0u}; cur[r] = (u32x4){0u, 0u, 0u, 0u};
            if (tt >= 0) { ccr[r] = *(const GAS u32x4*)(proj + PJ(tt, C_CC + c8)); cur[r] = *(const GAS u32x4*)(proj + PJ(tt, C_CU + c8)); } }
#pragma unroll
        for (int q = 0; q < 4; ++q) cbr[q] = *(const GAS u32x4*)(proj + PJ(t0 + q, C_CB + c8));
        f32x4 w[3][2], bias[2];
#pragma unroll
        for (int d = 0; d < 3; ++d) { w[d][0] = *(const GAS f32x4*)(cw + d * 256 + c8); w[d][1] = *(const GAS f32x4*)(cw + d * 256 + c8 + 4); }
        bias[0] = *(const GAS f32x4*)(cb_ + c8); bias[1] = *(const GAS f32x4*)(cb_ + c8 + 4);
        f32x4 z[6][2];
#pragma unroll
        for (int r = 0; r < 6; ++r) { f32x4 a0, a1, b0, b1; unpk8(ccr[r], a0, a1); unpk8(cur[r], b0, b1); z[r][0] = a0 * b0; z[r][1] = a1 * b1; }
#pragma unroll
        for (int q = 0; q < 4; ++q) {
            f32x4 g0, g1; unpk8(cbr[q], g0, g1);
            const f32x4 y0 = g0 * (bias[0] + z[q][0] * w[0][0] + z[q + 1][0] * w[1][0] + z[q + 2][0] * w[2][0]);
            const f32x4 y1 = g1 * (bias[1] + z[q][1] * w[0][1] + z[q + 1][1] * w[1][1] + z[q + 2][1] * w[2][1]);
            u32x4 o; o.x = cvt_pk_bf16(y0[0], y0[1]); o.y = cvt_pk_bf16(y0[2], y0[3]); o.z = cvt_pk_bf16(y1[0], y1[1]); o.w = cvt_pk_bf16(y1[2], y1[3]);
            *(GAS u32x4*)(mix + TX(t0 + q, MIX_CONV + c8)) = o;
        }
    }
}

struct Args { const float* in[16]; float* out; unsigned char* ws; int ph_lo, ph_hi; };

__global__ void __launch_bounds__(512, 2) fwd(Args a) {
    extern __shared__ __attribute__((aligned(16))) unsigned char lds_raw[];
    LAS unsigned char* lds = (LAS unsigned char*)lds_raw;
    cg::grid_group grid = cg::this_grid();
    const int ph_lo = a.ph_lo, ph_hi = a.ph_hi;
    const int wid0 = __builtin_amdgcn_readfirstlane(threadIdx.x >> 6);
    if (threadIdx.x < 2) ((LAS unsigned*)(lds + MISC_OFF))[threadIdx.x] = 0u;
    __syncthreads();
    (void)xcd_barrier_post((unsigned*)(a.ws + WS_CTL), (volatile LAS unsigned*)(lds + MISC_OFF));
    if (ph_hi > 100000) grid.sync();
    int rep = 0; bool first = true;
#pragma unroll 1
    for (int ph = ph_lo; ph < ph_hi; ++ph) {
        int wid_s = wid0; asm volatile("" : "+s"(wid_s));
        int tid; asm volatile("v_mbcnt_lo_u32_b32 %0, -1, 0\n\tv_mbcnt_hi_u32_b32 %0, -1, %0" : "=v"(tid));
        tid += wid_s * 64;
        int G = gridDim.x; asm volatile("" : "+s"(G));
        int bid = blockIdx.x; asm volatile("" : "+s"(bid));
        GAS unsigned char* ws = (GAS unsigned char*)a.ws; asm volatile("" : "+s"(ws));
        const int wid = __builtin_amdgcn_readfirstlane(tid >> 6), lane = tid & 63;
        if (!first) { XcdBarrier xb; xb.bar = (unsigned*)((unsigned char*)ws + WS_CTL); xb.x = xb_xcc_id(); xb.st = (volatile LAS unsigned*)(lds + MISC_OFF); xcd_barrier(xb, tid); }
        first = false;
        Ptrs P;
        P.x = (const GAS float*)a.in[0]; P.c = (const GAS float*)a.in[1]; P.w_ada = (const GAS float*)a.in[2]; P.b_ada = (const GAS float*)a.in[3]; P.g_mix = (const GAS float*)a.in[4]; P.w_in = (const GAS float*)a.in[5]; P.conv_w = (const GAS float*)a.in[6]; P.conv_b = (const GAS float*)a.in[7];
        P.q_norm = (const GAS float*)a.in[8]; P.k_norm = (const GAS float*)a.in[9]; P.sinks = (const GAS float*)a.in[10]; P.ret_gn = (const GAS float*)a.in[11]; P.w_out = (const GAS float*)a.in[12]; P.g_ffn = (const GAS float*)a.in[13]; P.w_gu = (const GAS float*)a.in[14]; P.w_down = (const GAS float*)a.in[15];
        P.out = (GAS float*)a.out; P.ws = ws;
        GAS bf16_t* xres = (GAS bf16_t*)(ws + WS_XR); GAS bf16_t* proj = (GAS bf16_t*)(ws + WS_PROJ); GAS bf16_t* act = (GAS bf16_t*)(ws + WS_PROJ); GAS bf16_t* mix = (GAS bf16_t*)(ws + WS_MIX);
        GAS float* kvT = (GAS float*)(ws + WS_KVT); GAS bf16_t* st = (GAS bf16_t*)(ws + WS_ST);
        const GAS unsigned* csT = (const GAS unsigned*)(ws + WS_COS);
        const GAS float* mod = (const GAS float*)(ws + WS_MOD); GAS unsigned* ssq = (GAS unsigned*)(ws + WS_SSQ);
        const int l = ph < NPRO ? 0 : (ph - NPRO) / 7, sub = ph < NPRO ? ph - NPRO : (ph - NPRO) % 7;
        const GAS float* modl = mod + l * 6144;
        if (ph == 0) { phase_p0(P, lds, tid, wid, lane, G, bid); }
        else if (ph == 1) { phase_p1(P, tid, G, bid); }
        else if (ph == 2) { phase_p2(P, lds, wid, lane, G, bid); }
        else if (ph == 3) { shw_reduce(ws, 0, bid * 512 + tid, G * 512); }
        else if (sub == 0) {
            pg8::Gemm g{(const bf16_t*)xres, (const bf16_t*)((unsigned char*)ws + WS_WIN) + (size_t)l * INP * DM, SEQ, INP, DM}; pg8::StaticOrder S; S.init(SEQ, INP, G, bid);
            EpiProj E{proj, ssq + (size_t)(2 * l) * SEQ, (const GAS float*)(ws + WS_SHWIN) + l * INP, csT, P.q_norm + l * 64, P.k_norm + l * 64};
            pg8::gemm_phase<EpiProj, pg8::StaticOrder, true, true, true, true>(lds, g, S, E, tid);
        } else if (sub == 1) {
            const bool aff = (G == 256); const int ax = bid & 7, aj = bid >> 3;
            if (aff) chunkkv_items3(lds, proj, kvT, 96 * ax + aj, 32, tid, wid, lane);
            else for (int it = bid; it < 768; it += 3 * G) chunkkv_items3(lds, proj, kvT, it, G, tid, wid, lane);
            for (int it = bid; it < 256; it += G) { const int q = aff ? 32 * ax + aj : it; swa_item(lds, proj, mix, P.sinks + l * 6, q >> 1, q & 1, tid, wid, lane); }
            conv_phase(proj, P.conv_w + l * 768, P.conv_b + l * 256, mix, tid, G, bid);
        } else if (sub == 2) { scan_phase(kvT, st, tid, G, bid);
        } else if (sub == 3) {
            const bool aff = (G == 256); const int ax = bid & 7, aj = bid >> 3;
            if (aff) retout_items(lds, proj, st, P.ret_gn + l * 384, mix, 96 * ax + aj, 32, 3, tid, wid, lane);
            else for (int it = bid; it < 768; it += G) retout_items(lds, proj, st, P.ret_gn + l * 384, mix, it, 0, 1, tid, wid, lane);
        } else if (sub == 4) {
            pg8::Gemm g{(const bf16_t*)mix, (const bf16_t*)((unsigned char*)ws + WS_WOUT) + (size_t)l * DM * DM, SEQ, DM, DM}; pg8::StaticOrder S; S.init(SEQ, DM, G, bid);
            EpiResid<true> E{xres, nullptr, modl + 2048, ssq + (size_t)(2 * l + 1) * SEQ};
#ifdef PROBE_SUB
            if (rep) { E.xres = (GAS bf16_t*)(ws + 320 * MiB); E.ssq_out = (GAS unsigned*)(ws + 352 * MiB); }
#endif
            pg8::gemm_phase<EpiResid<true>, pg8::StaticOrder, false, false, true, true>(lds, g, S, E, tid);
        } else if (sub == 5) {
            pg8::Gemm g{(const bf16_t*)xres, (const bf16_t*)((unsigned char*)ws + WS_WGU) + (size_t)l * GU * DM, SEQ, GU, DM}; pg8::StaticOrder S; S.init(SEQ, GU, G, bid);
            EpiGU E{act, ssq + (size_t)(2 * l + 1) * SEQ, (const GAS float*)(ws + WS_SHWGU) + l * GU};
            pg8::gemm_phase<EpiGU, pg8::StaticOrder, true, true, true, true>(lds, g, S, E, tid);
            if (l + 1 < NL && 2 * bid >= G && rep == 0) { LAS float* scr = (LAS float*)(lds + wid * 16384); const int nb = G - G / 2;
                for (int it = (bid - G / 2) * 8 + wid; it < I_L; it += nb * 8) convert_item(P, l + 1, it, scr, lane); }
        } else {
            pg8::Gemm g{(const bf16_t*)act, (const bf16_t*)((unsigned char*)ws + WS_WDN) + (size_t)l * DM * FH, SEQ, DM, FH}; pg8::StaticOrder S; S.init(SEQ, DM, G, bid);
            if (l == NL - 1) { EpiResid<false> E{xres, P.out, modl + 5120, nullptr};
                pg8::gemm_phase<EpiResid<false>, pg8::StaticOrder, true, true, true, true>(lds, g, S, E, tid); }
            else { EpiResid<true> E{xres, nullptr, modl + 5120, ssq + (size_t)(2 * l + 2) * SEQ};
#ifdef PROBE_SUB
                if (rep) { E.xres = (GAS bf16_t*)(ws + 320 * MiB); E.ssq_out = (GAS unsigned*)(ws + 352 * MiB); }
#endif
                pg8::gemm_phase<EpiResid<true>, pg8::StaticOrder, true, true, true, true>(lds, g, S, E, tid); }
            if (l + 1 < NL) shw_reduce(ws, l + 1, bid * 512 + tid, G * 512);
        }
#ifdef PROBE_SUB
        if (sub == PROBE_SUB && rep == 0 && !(PROBE_SUB == 6 && l == NL - 1)) { rep = 1; --ph; } else rep = 0;
#endif
#ifdef PROBE_SYNC
        for (int i = 0; i < PROBE_SYNC; ++i) { XcdBarrier xb; xb.bar = (unsigned*)((unsigned char*)ws + WS_CTL); xb.x = xb_xcc_id(); xb.st = (volatile LAS unsigned*)(lds + MISC_OFF); xcd_barrier(xb, tid); }
#endif
    }
}

extern "C" void kernel_launch(void* const* d_in, const int* in_sizes, int n_in, void* d_out, int out_size, void* d_ws, size_t ws_size, hipStream_t stream) {
    static int grid = 0;
    if (grid == 0) {
        if (n_in != 16 || out_size != SEQ * DM || ws_size < WS_END) { fprintf(stderr, "kernel_launch: unexpected shapes (n_in %d out %d ws %zu)\n", n_in, out_size, ws_size); grid = -1; return; }
        int dev = 0, cus = 0, per_cu = 0;
        hipGetDevice(&dev); hipDeviceGetAttribute(&cus, hipDeviceAttributeMultiprocessorCount, dev);
        hipFuncSetAttribute((const void*)fwd, hipFuncAttributeMaxDynamicSharedMemorySize, LDS_BYTES);
        hipOccupancyMaxActiveBlocksPerMultiprocessor(&per_cu, (const void*)fwd, 512, LDS_BYTES);
        if (per_cu < 1) { fprintf(stderr, "kernel_launch: occupancy query says %d blocks per CU\n", per_cu); per_cu = 1; }
        (void)hipGetLastError();
        grid = cus * 1;
    }
    if (grid < 0) return;
    if (hipMemsetAsync((char*)d_ws + WS_CTL, 0, CTL_BYTES, stream) != hipSuccess) { fprintf(stderr, "kernel_launch: memset of barrier words failed\n"); return; }
    Args a{};
    for (int i = 0; i < 16; ++i) a.in[i] = (const float*)d_in[i];
    a.out = (float*)d_out; a.ws = (unsigned char*)d_ws;
#if MK_MULTI
    for (int ph = 0; ph < NPH; ++ph) { a.ph_lo = ph; a.ph_hi = ph + 1; hipLaunchKernelGGL(fwd, dim3(grid), dim3(512), LDS_BYTES, stream, a); }
#else
    a.ph_lo = 0; a.ph_hi = NPH;
    void* args[] = {&a};
    hipError_t e = hipLaunchCooperativeKernel((const void*)fwd, dim3(grid), dim3(512), args, LDS_BYTES, stream);
    if (e != hipSuccess) fprintf(stderr, "cooperative launch failed: %s (grid %d)\n", hipGetErrorString(e), grid);
#endif
}
```
